# Optimizing an MI355X kernel written in HIP

```python
import math
import jax, jax.numpy as jnp
from jax import lax
import numpy as np

D_MODEL = 1024
BATCH = 8
SEQ = 4096
DEPTH = 2

EPS = 1e-6
D_FF = 2816
GLA_HEADS = 4
GLA_DK = 128
GLA_DV = 256
GLA_GATE_RANK = 16
GLA_GATE_TAU = 16.0
GLA_CHUNK = 64
GLA_QK = GLA_HEADS * GLA_DK
GLA_V = GLA_HEADS * GLA_DV
SSD_HEADS = 16
SSD_HEADDIM = 64
SSD_STATE = 128
SSD_GROUPS = 2
SSD_CONV = 4
SSD_CHUNK = 128
SSD_INNER = SSD_HEADS * SSD_HEADDIM
SSD_BC = SSD_GROUPS * SSD_STATE
SSD_CONV_CH = SSD_INNER + 2 * SSD_BC
HY_IN_SIZES = (GLA_QK, GLA_QK, GLA_V, GLA_V, GLA_GATE_RANK, SSD_INNER, SSD_CONV_CH, SSD_HEADS)
HY_IN_WIDTH = 2 * GLA_QK + 2 * GLA_V + GLA_GATE_RANK + SSD_INNER + SSD_CONV_CH + SSD_HEADS
MIX_WIDTH = GLA_V + SSD_INNER
DSA_HEADS = 16
DSA_Q_RANK = 256
DSA_LATENT = 128
DSA_VDIM = 64
IDX_HEADS = 16
IDX_DIM = 64
TOPK_MAX = 256
Q_BLOCK = 128
REL_BUCKETS = 32
REL_MAX_DIST = 128

kernel_name = 'hybrid_gla_ssd_dsa_macaron'


def rmsnorm(x, g):
    xf = x.astype(jnp.float32)
    y = xf * lax.rsqrt(jnp.mean(xf * xf, axis=-1, keepdims=True) + EPS)
    return (y * g.astype(jnp.float32)).astype(x.dtype)


def layernorm(x, g, b):
    xf = x.astype(jnp.float32)
    mu = jnp.mean(xf, axis=-1, keepdims=True)
    var = jnp.mean(jnp.square(xf - mu), axis=-1, keepdims=True)
    y = (xf - mu) * lax.rsqrt(var + EPS)
    return (y * g.astype(jnp.float32) + b.astype(jnp.float32)).astype(x.dtype)


def swiglu(h, wg, wu, wd):
    return (jax.nn.silu(h @ wg) * (h @ wu)) @ wd


def split_cols(t, sizes):
    idx = np.cumsum(np.array(sizes))[:-1].tolist()
    return jnp.split(t, idx, axis=-1)


def to_chunks(t, c):
    b, s = t.shape[0], t.shape[1]
    return jnp.moveaxis(t.reshape(b, s // c, c, *t.shape[2:]), 1, 0)


def from_chunks(t):
    t = jnp.moveaxis(t, 0, 1)
    return t.reshape(t.shape[0], t.shape[1] * t.shape[2], *t.shape[3:])


def causal_depthwise_conv(x, w, b):
    k, ch = w.shape
    y = lax.conv_general_dilated(x, w.reshape(k, 1, ch).astype(x.dtype), window_strides=(1,),
                                 padding=[(k - 1, 0)], dimension_numbers=('NWC', 'WIO', 'NWC'),
                                 feature_group_count=ch)
    return y + b.astype(x.dtype)


def gla_chunked(q, k, v, log_a):
    bsz, _, h, dk = q.shape
    dv = v.shape[-1]
    c = GLA_CHUNK
    mask = jnp.tril(jnp.ones((c, c), dtype=bool))[None, :, :, None, None]

    def step(state, inp):
        qc, kc, vc, gc = [t.astype(jnp.float32) for t in inp]
        b = jnp.cumsum(gc, axis=1)
        o_inter = jnp.einsum('bihk,bhkv->bihv', qc * jnp.exp(b), state)
        diff = b[:, :, None] - b[:, None]
        decay = jnp.exp(jnp.where(mask, diff, -jnp.inf))
        attn = jnp.einsum('bijhk,bjhk->bijh', qc[:, :, None] * decay, kc)
        o_intra = jnp.einsum('bijh,bjhv->bihv', attn, vc)
        b_last = b[:, -1]
        k_dec = kc * jnp.exp(b_last[:, None] - b)
        state = state * jnp.exp(b_last)[..., None] + jnp.einsum('bjhk,bjhv->bhkv', k_dec, vc)
        return state, o_inter + o_intra

    state0 = jnp.zeros((bsz, h, dk, dv), jnp.float32)
    _, o = lax.scan(step, state0, (to_chunks(q, c), to_chunks(k, c), to_chunks(v, c), to_chunks(log_a, c)))
    return from_chunks(o).astype(v.dtype)


def ssd_chunked(x, dt, a, bm, cm):
    bsz, _, h, p = x.shape
    n = bm.shape[-1]
    rep = h // bm.shape[2]
    c = SSD_CHUNK
    mask = jnp.tril(jnp.ones((c, c), dtype=bool))[None, :, :, None]

    def step(state, inp):
        xc, dtc, bc, cc = [t.astype(jnp.float32) for t in inp]
        bc = jnp.repeat(bc, rep, axis=2)
        cc = jnp.repeat(cc, rep, axis=2)
        acum = jnp.cumsum(dtc * a.astype(jnp.float32), axis=1)
        diff = acum[:, :, None] - acum[:, None]
        seg = jnp.exp(jnp.where(mask, diff, -jnp.inf))
        xdt = xc * dtc[..., None]
        scores = jnp.einsum('bihn,bjhn->bijh', cc, bc) * seg
        y_intra = jnp.einsum('bijh,bjhp->bihp', scores, xdt)
        y_inter = jnp.einsum('bihn,bhpn->bihp', cc * jnp.exp(acum)[..., None], state)
        a_last = acum[:, -1]
        w = jnp.exp(a_last[:, None] - acum)[..., None]
        state = state * jnp.exp(a_last)[..., None, None] + jnp.einsum('bjhn,bjhp->bhpn', bc * w, xdt)
        return state, y_intra + y_inter

    state0 = jnp.zeros((bsz, h, p, n), jnp.float32)
    _, y = lax.scan(step, state0, (to_chunks(x, c), to_chunks(dt, c), to_chunks(bm, c), to_chunks(cm, c)))
    return from_chunks(y).astype(x.dtype)


def gla_ssd_mixer(h, w_in, gla_w_gate2, gla_b_gate, gla_norm_g, ssd_conv_w, ssd_conv_b,
                  ssd_dt_bias, ssd_a_log, ssd_d, ssd_norm_g, w_out):
    bsz, s, _ = h.shape
    q, k, v, r, g_lr, z, xbc, dt = split_cols(h @ w_in, HY_IN_SIZES)
    q = q.reshape(bsz, s, GLA_HEADS, GLA_DK) * (GLA_DK ** -0.5)
    k = k.reshape(bsz, s, GLA_HEADS, GLA_DK)
    v = v.reshape(bsz, s, GLA_HEADS, GLA_DV)
    log_a = jax.nn.log_sigmoid((g_lr @ gla_w_gate2 + gla_b_gate).astype(jnp.float32)) / GLA_GATE_TAU
    o_gla = gla_chunked(q, k, v, log_a.reshape(bsz, s, GLA_HEADS, GLA_DK))
    o_gla = rmsnorm(o_gla, gla_norm_g.reshape(GLA_HEADS, GLA_DV)).reshape(bsz, s, GLA_V)
    o_gla = o_gla * jax.nn.silu(r)
    xbc = jax.nn.silu(causal_depthwise_conv(xbc, ssd_conv_w, ssd_conv_b))
    xs, bm, cm = split_cols(xbc, (SSD_INNER, SSD_BC, SSD_BC))
    xs = xs.reshape(bsz, s, SSD_HEADS, SSD_HEADDIM)
    dt = jax.nn.softplus((dt + ssd_dt_bias).astype(jnp.float32))
    a = -jnp.exp(ssd_a_log.astype(jnp.float32))
    y = ssd_chunked(xs, dt, a, bm.reshape(bsz, s, SSD_GROUPS, SSD_STATE), cm.reshape(bsz, s, SSD_GROUPS, SSD_STATE))
    y = (y + ssd_d[:, None].astype(y.dtype) * xs).reshape(bsz, s, SSD_INNER) * jax.nn.silu(z)
    y = rmsnorm(y.reshape(bsz, s, SSD_GROUPS, SSD_INNER // SSD_GROUPS),
                ssd_norm_g.reshape(SSD_GROUPS, SSD_INNER // SSD_GROUPS)).reshape(bsz, s, SSD_INNER)
    return jnp.concatenate([o_gla, y], axis=-1) @ w_out


def t5_bucket(rel):
    max_exact = REL_BUCKETS // 2
    relf = jnp.maximum(rel, 1).astype(jnp.float32)
    large = max_exact + (jnp.log(relf / max_exact) / math.log(REL_MAX_DIST / max_exact)
                         * (REL_BUCKETS - max_exact)).astype(jnp.int32)
    large = jnp.minimum(large, REL_BUCKETS - 1)
    return jnp.where(rel < max_exact, rel, large)


def dsa_mixer(h, w_dq, q_norm_g, w_uq, w_dkv, kv_norm_g, w_uv, w_o,
              idx_w_q, idx_w_k, idx_ln_g, idx_ln_b, idx_w_w, rel_bias):
    bsz, s, _ = h.shape
    q_lat = rmsnorm(h @ w_dq, q_norm_g)
    q = (q_lat @ w_uq).reshape(bsz, s, DSA_HEADS, DSA_LATENT)
    kv = rmsnorm(h @ w_dkv, kv_norm_g)
    q_idx = (q_lat @ idx_w_q).reshape(bsz, s, IDX_HEADS, IDX_DIM)
    k_idx = layernorm(h @ idx_w_k, idx_ln_g, idx_ln_b)
    w_idx = (h @ idx_w_w) * (IDX_HEADS ** -0.5 * IDX_DIM ** -0.5)
    topk = min(TOPK_MAX, s // 4)
    nb = s // Q_BLOCK
    key_pos = jnp.arange(s)

    def one_block(inp):
        qb, qib, wb, start = inp
        qpos = start + jnp.arange(Q_BLOCK)
        idx_logits = jnp.einsum('bqhd,bsd->bqhs', qib, k_idx).astype(jnp.float32)
        score = jnp.einsum('bqhs,bqh->bqs', jax.nn.relu(idx_logits), wb.astype(jnp.float32))
        score = jnp.where((key_pos[None, :] <= qpos[:, None])[None], score, -jnp.inf)
        _, sel = lax.top_k(score, topk)
        valid = sel <= qpos[None, :, None]
        kv_sel = jax.vmap(lambda kvb, ib: kvb[ib])(kv, sel)
        logits = jnp.einsum('bqhc,bqkc->bqhk', qb, kv_sel).astype(jnp.float32) * (DSA_LATENT ** -0.5)
        bias = rel_bias[t5_bucket(jnp.maximum(qpos[None, :, None] - sel, 0))]
        logits = logits + jnp.moveaxis(bias, 3, 2).astype(jnp.float32)
        logits = jnp.where(valid[:, :, None, :], logits, -jnp.inf)
        p = jax.nn.softmax(logits, axis=-1).astype(kv.dtype)
        return jnp.einsum('bqhk,bqkc->bqhc', p, kv_sel)

    o_lat = lax.map(one_block, (to_chunks(q, Q_BLOCK), to_chunks(q_idx, Q_BLOCK),
                                to_chunks(w_idx, Q_BLOCK), jnp.arange(nb) * Q_BLOCK))
    o_lat = from_chunks(o_lat)
    o = jnp.einsum('bshc,hcd->bshd', o_lat, w_uv).reshape(bsz, s, DSA_HEADS * DSA_VDIM)
    return o @ w_o


def setup_inputs(seed: int = 0) -> dict:
    key = jax.random.key(seed)
    keys = jax.random.split(key, 64)
    counter = [0]

    def nk():
        counter[0] += 1
        return keys[counter[0] - 1]

    def w(shape, fan_in):
        return jax.random.normal(nk(), shape, jnp.float32) * (fan_in ** -0.5)

    def gain(shape):
        return 1.0 + 0.02 * jax.random.normal(nk(), shape, jnp.float32)

    def small(shape, scale=0.02):
        return scale * jax.random.normal(nk(), shape, jnp.float32)

    ne, no = (DEPTH + 1) // 2, DEPTH // 2
    x = jax.random.normal(nk(), (BATCH, SEQ, D_MODEL), jnp.float32)
    dt0 = jnp.exp(jax.random.uniform(nk(), (ne, SSD_HEADS), jnp.float32, math.log(1e-3), math.log(1e-1)))
    ssd_dt_bias = dt0 + jnp.log(-jnp.expm1(-dt0))
    ssd_a_log = jnp.log(jax.random.uniform(nk(), (ne, SSD_HEADS), jnp.float32, 1.0, 16.0))
    return {
        'x': x,
        'ffn_norm_g': gain((DEPTH, 2, D_MODEL)),
        'ffn_w_gate': w((DEPTH, 2, D_MODEL, D_FF), D_MODEL),
        'ffn_w_up': w((DEPTH, 2, D_MODEL, D_FF), D_MODEL),
        'ffn_w_down': w((DEPTH, 2, D_FF, D_MODEL), D_FF),
        'mix_norm_g': gain((DEPTH, D_MODEL)),
        'hy_w_in': w((ne, D_MODEL, HY_IN_WIDTH), D_MODEL),
        'gla_w_gate2': w((ne, GLA_GATE_RANK, GLA_QK), GLA_GATE_RANK),
        'gla_b_gate': small((ne, GLA_QK), 0.1),
        'gla_norm_g': gain((ne, GLA_V)),
        'ssd_conv_w': w((ne, SSD_CONV, SSD_CONV_CH), SSD_CONV),
        'ssd_conv_b': small((ne, SSD_CONV_CH)),
        'ssd_dt_bias': ssd_dt_bias,
        'ssd_a_log': ssd_a_log,
        'ssd_d': gain((ne, SSD_HEADS)),
        'ssd_norm_g': gain((ne, SSD_INNER)),
        'hy_w_out': w((ne, MIX_WIDTH, D_MODEL), MIX_WIDTH),
        'dsa_w_dq': w((no, D_MODEL, DSA_Q_RANK), D_MODEL),
        'dsa_q_norm_g': gain((no, DSA_Q_RANK)),
        'dsa_w_uq': w((no, DSA_Q_RANK, DSA_HEADS * DSA_LATENT), DSA_Q_RANK),
        'dsa_w_dkv': w((no, D_MODEL, DSA_LATENT), D_MODEL),
        'dsa_kv_norm_g': gain((no, DSA_LATENT)),
        'dsa_w_uv': w((no, DSA_HEADS, DSA_LATENT, DSA_VDIM), DSA_LATENT),
        'dsa_w_o': w((no, DSA_HEADS * DSA_VDIM, D_MODEL), DSA_HEADS * DSA_VDIM),
        'idx_w_q': w((no, DSA_Q_RANK, IDX_HEADS * IDX_DIM), DSA_Q_RANK),
        'idx_w_k': w((no, D_MODEL, IDX_DIM), D_MODEL),
        'idx_ln_g': gain((no, IDX_DIM)),
        'idx_ln_b': small((no, IDX_DIM)),
        'idx_w_w': w((no, D_MODEL, IDX_HEADS), D_MODEL),
        'rel_bias': small((REL_BUCKETS, DSA_HEADS), 0.5),
        'final_norm_g': gain((D_MODEL,)),
    }


def reference(x, ffn_norm_g, ffn_w_gate, ffn_w_up, ffn_w_down, mix_norm_g,
              hy_w_in, gla_w_gate2, gla_b_gate, gla_norm_g, ssd_conv_w, ssd_conv_b,
              ssd_dt_bias, ssd_a_log, ssd_d, ssd_norm_g, hy_w_out,
              dsa_w_dq, dsa_q_norm_g, dsa_w_uq, dsa_w_dkv, dsa_kv_norm_g, dsa_w_uv, dsa_w_o,
              idx_w_q, idx_w_k, idx_ln_g, idx_ln_b, idx_w_w, rel_bias, final_norm_g):
    for layer in range(DEPTH):
        h = rmsnorm(x, ffn_norm_g[layer, 0])
        x = x + 0.5 * swiglu(h, ffn_w_gate[layer, 0], ffn_w_up[layer, 0], ffn_w_down[layer, 0])
        h = rmsnorm(x, mix_norm_g[layer])
        i = layer // 2
        if layer % 2 == 0:
            x = x + gla_ssd_mixer(h, hy_w_in[i], gla_w_gate2[i], gla_b_gate[i], gla_norm_g[i],
                                  ssd_conv_w[i], ssd_conv_b[i], ssd_dt_bias[i], ssd_a_log[i],
                                  ssd_d[i], ssd_norm_g[i], hy_w_out[i])
        else:
            x = x + dsa_mixer(h, dsa_w_dq[i], dsa_q_norm_g[i], dsa_w_uq[i], dsa_w_dkv[i],
                              dsa_kv_norm_g[i], dsa_w_uv[i], dsa_w_o[i], idx_w_q[i], idx_w_k[i],
                              idx_ln_g[i], idx_ln_b[i], idx_w_w[i], rel_bias)
        h = rmsnorm(x, ffn_norm_g[layer, 1])
        x = x + 0.5 * swiglu(h, ffn_w_gate[layer, 1], ffn_w_up[layer, 1], ffn_w_down[layer, 1])
    return rmsnorm(x, final_norm_g)
```

```cpp
#include <hip/hip_runtime.h>
#include <hip/hip_cooperative_groups.h>
#include <cstdio>
#include <cstdint>
namespace cg = cooperative_groups;

#include <hip/hip_runtime.h>
namespace pg8 {
#define PG8_LAS __attribute__((address_space(3)))
typedef unsigned short bf16_t;
typedef short bf16x8 __attribute__((ext_vector_type(8)));
typedef float f32x4 __attribute__((ext_vector_type(4)));
typedef unsigned u32x4 __attribute__((ext_vector_type(4)));
constexpr int BM = 256, BK = 64, HALF = 128, HTB = HALF * BK * 2  , STAGE_BYTES = 8 * HTB, NXCD = 8, WGM = 8;

__host__ __device__ __forceinline__ int lds_byte(int r, int c) { const int st = (r >> 4) * 2 + (c >> 5), rr = r & 15, cc = c & 31, ob = rr * 64 + cc * 2; return st * 1024 + (ob ^ (((ob >> 9) & 1) << 5)); }
__host__ __device__ __forceinline__ void stage_rc(int b, int& R, int& C) { const int st = b / 1024, sb = b % 1024, swz = sb ^ (((sb >> 9) & 1) << 5); R = (st >> 1) * 16 + swz / 64; C = (st & 1) * 32 + (swz % 64) / 2; }
__host__ __device__ __forceinline__ int perm32(int rho) { const int n = rho >> 4, i = rho & 15; return 8 * (i >> 2) + 4 * n + (i & 3); }

struct Unit { int pm, pn; };
struct Gemm { const bf16_t* A; const bf16_t* Bt; int M, N, K, lda; };

struct StaticOrder {
    int nM, nN, nwg, G, c;
    __host__ __device__ void init(int M, int N, int G_, int c_) { nM = M / BM; nN = N / BM; nwg = nM * nN; G = G_; c = c_; }
    __host__ __device__ bool next(int i, Unit& u) const {
        const long L = (long)i * G + c; if (L >= nwg) return false;
        int wgid = (int)L; { const int q = nwg / NXCD, r = nwg % NXCD, xcd = wgid % NXCD, off = wgid / NXCD; wgid = (xcd < r ? xcd * (q + 1) : r * (q + 1) + (xcd - r) * q) + off; }
        const int nig = WGM * nN, gid = wgid / nig, fm = gid * WGM, gsz = (nM - fm) < WGM ? (nM - fm) : WGM;
        u.pm = fm + ((wgid % nig) % gsz); u.pn = (wgid % nig) / gsz; return true;
    }
    __device__ __forceinline__ void a_ready(const Unit&) const {}
    __device__ __forceinline__ void done(const Unit&) const {}
};

__device__ __forceinline__ unsigned cvt_pk_bf16(float lo, float hi) { unsigned r; asm volatile("v_cvt_pk_bf16_f32 %0, %1, %2" : "=v"(r) : "v"(lo), "v"(hi)); return r; }

template <class Epi, class Sched>
__device__ __forceinline__ void gemm_phase(PG8_LAS unsigned char* lds, const Gemm g, const Sched& S, const Epi& E) {
    const int tid = threadIdx.x, wid = __builtin_amdgcn_readfirstlane(tid >> 6), lane = tid & 63, wr = wid >> 2, wc = wid & 3, fr = lane & 15, fq = lane >> 4;
    const int K = g.K, nt = K / BK;
    unsigned voffA[2], voffB[2];
#pragma unroll
    for (int i = 0; i < 2; ++i) { int R, C; stage_rc(tid * 16 + i * 8192, R, C); const int Rb = Epi::PERM ? ((R & ~31) + perm32(R & 31)) : R;
        voffA[i] = (unsigned)(R * g.lda + C) * 2u; voffB[i] = (unsigned)(Rb * K + C) * 2u; }
    const size_t kstep = (size_t)(BK * 2);
    const size_t hstep = (size_t)HALF * K * 2;
    const size_t hstepA = (size_t)HALF * g.lda * 2, tstepA = 2 * hstepA;
    const size_t tstep = 2 * hstep;
    const unsigned ldsw = (unsigned)wid * 1024u;
    const int aoff = lds_byte(wr * 64 + fr, fq * 8), boff = lds_byte(wc * 32 + fr, fq * 8);
#define PG8_SA(b, h) (((b) * 2 + (h)) * HTB)
#define PG8_SB(b, h) ((4 + (b) * 2 + (h)) * HTB)
#define PG8_STAGE(bufoff, gbase, voff) do { _Pragma("unroll") for (int _i = 0; _i < 2; ++_i) \
        __builtin_amdgcn_global_load_lds((const unsigned*)((const char*)(gbase) + (voff)[_i]), (PG8_LAS unsigned*)(lds + (bufoff) + ldsw + _i * 8192), 16, 0, 0); } while (0)
#define PG8_LDA(dst, b, h) do { _Pragma("unroll") for (int m = 0; m < 4; ++m) _Pragma("unroll") for (int k = 0; k < 2; ++k) dst[m][k] = *(const PG8_LAS bf16x8*)(lds + PG8_SA(b, h) + aoff + m * 2048 + k * 1024); } while (0)
#define PG8_LDB(dst, b, h) do { _Pragma("unroll") for (int n = 0; n < 2; ++n) _Pragma("unroll") for (int k = 0; k < 2; ++k) dst[n][k] = *(const PG8_LAS bf16x8*)(lds + PG8_SB(b, h) + boff + n * 2048 + k * 1024); } while (0)
#define PG8_MMA(ai, bj, At, Bt) do { __builtin_amdgcn_s_setprio(1); _Pragma("unroll") for (int m = 0; m < 4; ++m) _Pragma("unroll") for (int n = 0; n < 2; ++n) _Pragma("unroll") for (int k = 0; k < 2; ++k) \
        acc[ai][bj][m][n] = __builtin_amdgcn_mfma_f32_16x16x32_bf16(Bt[n][k], At[m][k], acc[ai][bj][m][n], 0, 0, 0); __builtin_amdgcn_s_setprio(0); } while (0)
#define PG8_WAIT_V(n) asm volatile("s_waitcnt vmcnt(" #n ")" ::: "memory")
#define PG8_WAIT_L(n) asm volatile("s_waitcnt lgkmcnt(" #n ")" ::: "memory")
#define PG8_BAR __builtin_amdgcn_s_barrier()
#define PG8_SCHED __builtin_amdgcn_sched_barrier(0)
    Unit cur, nxt; int ui = 0;
    if (!S.next(0, cur)) return;
    f32x4 acc[2][2][4][2];
#pragma unroll
    for (int a = 0; a < 2; ++a)
#pragma unroll
        for (int b = 0; b < 2; ++b)
#pragma unroll
            for (int m = 0; m < 4; ++m)
#pragma unroll
                for (int n = 0; n < 2; ++n) acc[a][b][m][n] = (f32x4){0.f, 0.f, 0.f, 0.f};
    bf16x8 At[4][2], B0[2][2], B1[2][2];
    const char* cA = (const char*)g.A + (size_t)cur.pm * tstepA; const char* cB = (const char*)g.Bt + (size_t)cur.pn * tstep;
    S.a_ready(cur);
    PG8_STAGE(PG8_SB(0, 0), cB, voffB); PG8_STAGE(PG8_SA(0, 0), cA, voffA); PG8_STAGE(PG8_SB(0, 1), cB + hstep, voffB); PG8_STAGE(PG8_SA(0, 1), cA + hstepA, voffA);
    if (wr == 1) PG8_BAR;
    PG8_WAIT_V(4); PG8_BAR;
    PG8_STAGE(PG8_SB(1, 0), cB + kstep, voffB); PG8_STAGE(PG8_SA(1, 0), cA + kstep, voffA); PG8_STAGE(PG8_SB(1, 1), cB + hstep + kstep, voffB);
    PG8_WAIT_V(6); PG8_BAR;
    for (;;) {
        const bool has_next = S.next(ui + 1, nxt);
        const char* nA = has_next ? (const char*)g.A + (size_t)nxt.pm * tstepA : cA; const char* nB = has_next ? (const char*)g.Bt + (size_t)nxt.pn * tstep : cB;
        for (int t = 0; t < nt; t += 2) {
            const bool last = (t == nt - 2);
            const char* a1 = cA + (size_t)(t + 1) * kstep;
            const char* a2 = last ? nA : cA + (size_t)(t + 2) * kstep; const char* b2 = last ? nB : cB + (size_t)(t + 2) * kstep;
            const char* a3 = a2 + kstep; const char* b3 = b2 + kstep;
            if (last && has_next) S.a_ready(nxt);
            PG8_LDB(B0, 0, 0); PG8_SCHED; PG8_LDA(At, 0, 0); PG8_STAGE(PG8_SA(1, 1), a1 + hstepA, voffA);
            PG8_WAIT_L(8); PG8_BAR; PG8_WAIT_L(0); PG8_MMA(0, 0, At, B0); PG8_BAR; PG8_SCHED;
            PG8_LDB(B1, 0, 1); PG8_STAGE(PG8_SB(0, 0), b2, voffB);
            PG8_BAR; PG8_WAIT_L(0); PG8_MMA(0, 1, At, B1); PG8_BAR;
            PG8_LDA(At, 0, 1); PG8_STAGE(PG8_SA(0, 0), a2, voffA);
            PG8_BAR; PG8_WAIT_L(0); PG8_MMA(1, 0, At, B0); PG8_BAR; PG8_SCHED;
            PG8_STAGE(PG8_SB(0, 1), b2 + hstep, voffB);
            PG8_WAIT_V(6); PG8_BAR; PG8_MMA(1, 1, At, B1); PG8_BAR;
            PG8_LDB(B0, 1, 0); PG8_SCHED; PG8_LDA(At, 1, 0); PG8_STAGE(PG8_SA(0, 1), a2 + hstepA, voffA);
            PG8_WAIT_L(8); PG8_BAR; PG8_WAIT_L(0); PG8_MMA(0, 0, At, B0); PG8_BAR; PG8_SCHED;
            PG8_LDB(B1, 1, 1); PG8_STAGE(PG8_SB(1, 0), b3, voffB);
            PG8_BAR; PG8_WAIT_L(0); PG8_MMA(0, 1, At, B1); PG8_BAR;
            PG8_LDA(At, 1, 1); PG8_STAGE(PG8_SA(1, 0), a3, voffA);
            PG8_BAR; PG8_WAIT_L(0); PG8_MMA(1, 0, At, B0); PG8_BAR; PG8_SCHED;
            PG8_STAGE(PG8_SB(1, 1), b3 + hstep, voffB);
            PG8_WAIT_V(6); PG8_BAR; PG8_MMA(1, 1, At, B1); PG8_BAR;
        }
        if constexpr (!Epi::AFTER_DRAIN) { E(acc, cur, wr, wc, fr, fq); S.done(cur); }
        if (!has_next) break;
#pragma unroll
        for (int a = 0; a < 2; ++a)
#pragma unroll
            for (int b = 0; b < 2; ++b)
#pragma unroll
                for (int m = 0; m < 4; ++m)
#pragma unroll
                    for (int n = 0; n < 2; ++n) acc[a][b][m][n] = (f32x4){0.f, 0.f, 0.f, 0.f};
        cur = nxt; cA = nA; cB = nB; ++ui;
    }
    PG8_WAIT_V(0);
    if (wr == 0) PG8_BAR;
    PG8_BAR;
    if constexpr (Epi::AFTER_DRAIN) { E.fused(acc, cur, wr, wc, fr, fq, lds, wid, lane); S.done(cur); }
#undef PG8_SA
#undef PG8_SB
#undef PG8_STAGE
#undef PG8_LDA
#undef PG8_LDB
#undef PG8_MMA
#undef PG8_WAIT_V
#undef PG8_WAIT_L
#undef PG8_BAR
#undef PG8_SCHED
}
}

using pg8::bf16_t; using pg8::bf16x8; using pg8::f32x4; using pg8::u32x4; using pg8::cvt_pk_bf16;
#define LAS __attribute__((address_space(3)))
typedef unsigned short u16x4 __attribute__((ext_vector_type(4)));
typedef unsigned u32x2 __attribute__((ext_vector_type(2)));

constexpr int T_TOK = 32768, SEQ = 4096, DM = 1024, DFF = 2816;
constexpr int IN_LD = 5632;
constexpr int C_Q = 0, C_K = 512, C_V = 1024, C_R = 2048, C_Z = 3072, C_X = 4096, C_B = 5120, C_C = 5376;
constexpr size_t MiB = 1024 * 1024;
constexpr size_t WS_IN = 0;
constexpr size_t WS_ACT = 0;
constexpr size_t WS_Q = 0;
constexpr size_t WS_QIDX = 128 * MiB;
constexpr size_t WS_RAW1 = 192 * MiB;
constexpr size_t WS_QLAT = 256 * MiB;
constexpr size_t WS_KV = 272 * MiB;
constexpr size_t WS_KIDX = 280 * MiB;
constexpr size_t WS_WIDX = 284 * MiB;
constexpr size_t WS_XB = 352 * MiB;
constexpr size_t WS_SS = 416 * MiB;
constexpr size_t WS_SMALL = 418 * MiB;
constexpr size_t WS_W = 422 * MiB;
constexpr size_t W_GU = WS_W;
constexpr size_t W_GU_SZ = (size_t)5632 * 1024 * 2;
constexpr size_t W_D = W_GU + 4 * W_GU_SZ;
constexpr size_t W_D_SZ = (size_t)1024 * 2816 * 2;
constexpr size_t W_IN = W_D + 4 * W_D_SZ;
constexpr size_t W_OUT = W_IN + (size_t)5888 * 1024 * 2;
constexpr size_t W_D1 = W_OUT + (size_t)1024 * 2048 * 2;
constexpr size_t W_D3 = W_D1 + (size_t)512 * 1024 * 2;
constexpr size_t W_C = W_D3 + (size_t)3072 * 256 * 2;
constexpr size_t WS_END = W_C + (size_t)1024 * 2048 * 2;
static_assert(WS_END <= 512 * MiB, "workspace");
constexpr int LDS_BYTES = 147456;

struct Params { const float* in[31]; float* out; unsigned char* ws; int ph_lo, ph_hi; };

__device__ __forceinline__ float bf2f(bf16_t v) { return __uint_as_float(((unsigned)v) << 16); }
__device__ __forceinline__ bf16_t f2bf(float f) { unsigned u = __float_as_uint(f); u += 0x7FFFu + ((u >> 16) & 1u); return (bf16_t)(u >> 16); }
__device__ __forceinline__ float wave_sum(float v) { v += __shfl_xor(v, 32); v += __shfl_xor(v, 16); v += __shfl_xor(v, 8); v += __shfl_xor(v, 4); v += __shfl_xor(v, 2); v += __shfl_xor(v, 1); return v; }
__device__ __forceinline__ float silu_f(float x) { return x / (1.0f + __expf(-x)); }
__device__ __forceinline__ float row_rstd(const float* ss, int row) {
    const f32x4* p = (const f32x4*)(ss + (size_t)row * 16); const f32x4 a = p[0], b = p[1], c = p[2], d = p[3];
    const float s = (((a[0] + a[1]) + (a[2] + a[3])) + ((b[0] + b[1]) + (b[2] + b[3]))) + (((c[0] + c[1]) + (c[2] + c[3])) + ((d[0] + d[1]) + (d[2] + d[3])));
    return rsqrtf(s * (1.0f / 1024.0f) + 1e-6f);
}

struct EpiGU {
    static constexpr bool PERM = true, AFTER_DRAIN = false;
    bf16_t* act; const float* ss;
    __device__ __forceinline__ void operator()(const f32x4 (&acc)[2][2][4][2], const pg8::Unit& u, int wr, int wc, int fr, int fq) const {
        const int row0 = u.pm * 256 + wr * 64 + fr, col0 = u.pn * 128 + wc * 32 + 8 * fq;
#pragma unroll
        for (int ai = 0; ai < 2; ++ai)
#pragma unroll
            for (int m = 0; m < 4; ++m) { const int r = row0 + ai * 128 + m * 16; const float rs = row_rstd(ss, r);
                float o[8];
#pragma unroll
                for (int n = 0; n < 2; ++n)
#pragma unroll
                    for (int e = 0; e < 4; ++e) { const float g = acc[ai][0][m][n][e] * rs, up = acc[ai][1][m][n][e] * rs; o[n * 4 + e] = silu_f(g) * up; }
                u32x4 w; w.x = cvt_pk_bf16(o[0], o[1]); w.y = cvt_pk_bf16(o[2], o[3]); w.z = cvt_pk_bf16(o[4], o[5]); w.w = cvt_pk_bf16(o[6], o[7]);
                *(u32x4*)(act + (size_t)r * DFF + col0) = w; }
    }
};
struct EpiRes {
    static constexpr bool PERM = false, AFTER_DRAIN = false;
    const float* res; float* X; bf16_t* XB; float* ss;
    __device__ __forceinline__ void operator()(const f32x4 (&acc)[2][2][4][2], const pg8::Unit& u, int wr, int wc, int fr, int fq) const {
        const int row0 = u.pm * 256 + wr * 64 + fr, col0 = u.pn * 256 + wc * 32 + 4 * fq;
#pragma unroll
        for (int ai = 0; ai < 2; ++ai)
#pragma unroll
            for (int m = 0; m < 4; ++m) { const int r = row0 + ai * 128 + m * 16; float sq = 0.f;
#pragma unroll
                for (int bj = 0; bj < 2; ++bj)
#pragma unroll
                    for (int n = 0; n < 2; ++n) { const size_t o = (size_t)r * DM + col0 + bj * 128 + n * 16;
                        const f32x4 v = *(const f32x4*)(res + o) + acc[ai][bj][m][n];
                        *(f32x4*)(X + o) = v; sq += (v[0] * v[0] + v[1] * v[1]) + (v[2] * v[2] + v[3] * v[3]);
                        u32x2 w; w.x = cvt_pk_bf16(v[0], v[1]); w.y = cvt_pk_bf16(v[2], v[3]); *(u32x2*)(XB + o) = w; }
                sq += __shfl_xor(sq, 16); sq += __shfl_xor(sq, 32);
                if (fq == 0) ss[(size_t)r * 16 + u.pn * 4 + wc] = sq; }
    }
};
struct EpiIn {
    static constexpr bool PERM = true, AFTER_DRAIN = false;
    bf16_t* IN; float* small; const float* ss;
    __device__ __forceinline__ void operator()(const f32x4 (&acc)[2][2][4][2], const pg8::Unit& u, int wr, int wc, int fr, int fq) const {
        const int row0 = u.pm * 256 + wr * 64 + fr, col0 = u.pn * 256 + wc * 32 + 8 * fq;
#pragma unroll
        for (int ai = 0; ai < 2; ++ai)
#pragma unroll
            for (int m = 0; m < 4; ++m) { const int r = row0 + ai * 128 + m * 16; const float rs = row_rstd(ss, r);
                if (u.pn < 22) {
#pragma unroll
                    for (int bj = 0; bj < 2; ++bj) { const f32x4 v0 = acc[ai][bj][m][0] * rs, v1 = acc[ai][bj][m][1] * rs;
                        u32x4 w; w.x = cvt_pk_bf16(v0[0], v0[1]); w.y = cvt_pk_bf16(v0[2], v0[3]); w.z = cvt_pk_bf16(v1[0], v1[1]); w.w = cvt_pk_bf16(v1[2], v1[3]);
                        *(u32x4*)(IN + (size_t)r * IN_LD + col0 + bj * 128) = w; }
                } else if (wc == 0) {
                    *(f32x4*)(small + (size_t)r * 32 + 8 * fq) = acc[ai][0][m][0] * rs; *(f32x4*)(small + (size_t)r * 32 + 8 * fq + 4) = acc[ai][0][m][1] * rs; }
            }
    }
};
struct EpiD1 {
    static constexpr bool PERM = false, AFTER_DRAIN = false;
    float* raw; const float* ss;
    __device__ __forceinline__ void operator()(const f32x4 (&acc)[2][2][4][2], const pg8::Unit& u, int wr, int wc, int fr, int fq) const {
        const int row0 = u.pm * 256 + wr * 64 + fr, col0 = u.pn * 256 + wc * 32 + 4 * fq;
#pragma unroll
        for (int ai = 0; ai < 2; ++ai)
#pragma unroll
            for (int m = 0; m < 4; ++m) { const int r = row0 + ai * 128 + m * 16; const float rs = row_rstd(ss, r);
#pragma unroll
                for (int bj = 0; bj < 2; ++bj)
#pragma unroll
                    for (int n = 0; n < 2; ++n) *(f32x4*)(raw + (size_t)r * 512 + col0 + bj * 128 + n * 16) = acc[ai][bj][m][n] * rs; }
    }
};
struct EpiD3 {
    static constexpr bool PERM = true, AFTER_DRAIN = false;
    bf16_t* Q; bf16_t* QI;
    __device__ __forceinline__ void operator()(const f32x4 (&acc)[2][2][4][2], const pg8::Unit& u, int wr, int wc, int fr, int fq) const {
        const int row0 = u.pm * 256 + wr * 64 + fr; const bool isq = u.pn < 8;
        bf16_t* base = isq ? Q : QI; const int ld = isq ? 2048 : 1024; const int col0 = (isq ? u.pn : u.pn - 8) * 256 + wc * 32 + 8 * fq;
#pragma unroll
        for (int ai = 0; ai < 2; ++ai)
#pragma unroll
            for (int m = 0; m < 4; ++m) { const int r = row0 + ai * 128 + m * 16;
#pragma unroll
                for (int bj = 0; bj < 2; ++bj) { const f32x4 v0 = acc[ai][bj][m][0], v1 = acc[ai][bj][m][1];
                    u32x4 w; w.x = cvt_pk_bf16(v0[0], v0[1]); w.y = cvt_pk_bf16(v0[2], v0[3]); w.z = cvt_pk_bf16(v1[0], v1[1]); w.w = cvt_pk_bf16(v1[2], v1[3]);
                    *(u32x4*)(base + (size_t)r * ld + col0 + bj * 128) = w; } }
    }
};
template <class Epi> __device__ __forceinline__ void run_gemm(LAS unsigned char* lds, const bf16_t* A, int lda, const bf16_t* Bt, int M, int N, int K, const Epi& E) {
    pg8::Gemm g; g.A = A; g.Bt = Bt; g.M = M; g.N = N; g.K = K; g.lda = lda;
    pg8::StaticOrder S; S.init(M, N, (int)gridDim.x, (int)blockIdx.x);
    pg8::gemm_phase<Epi, pg8::StaticOrder>(lds, g, S, E);
}

struct PrepJob { const float* src; int src_ld, col0, ncols, K; bf16_t* dst; int grp, grp_stride, grp_off; const float* gain; float scale; };
__device__ __forceinline__ PrepJob mkjob(const float* src, int src_ld, int col0, int ncols, int K, bf16_t* dst, int grp, int gs, int go, const float* gain, float scale) {
    PrepJob j; j.src = src; j.src_ld = src_ld; j.col0 = col0; j.ncols = ncols; j.K = K; j.dst = dst; j.grp = grp; j.grp_stride = gs; j.grp_off = go; j.gain = gain; j.scale = scale; return j; }
__device__ PrepJob get_job(const Params& p, int j) {
    const int BIG = 1 << 30; unsigned char* ws = p.ws;
    if (j < 12) { const int lf = j / 3, k = j % 3;
        if (k == 0) return mkjob(p.in[2] + (size_t)lf * 1024 * 2816, 2816, 0, 2816, 1024, (bf16_t*)(ws + W_GU + lf * W_GU_SZ), 128, 256, 0, p.in[1] + lf * 1024, 1.0f);
        if (k == 1) return mkjob(p.in[3] + (size_t)lf * 1024 * 2816, 2816, 0, 2816, 1024, (bf16_t*)(ws + W_GU + lf * W_GU_SZ), 128, 256, 128, p.in[1] + lf * 1024, 1.0f);
        return mkjob(p.in[4] + (size_t)lf * 2816 * 1024, 1024, 0, 1024, 2816, (bf16_t*)(ws + W_D + lf * W_D_SZ), BIG, 0, 0, nullptr, 0.5f); }
    j -= 12;
    if (j < 8) { bf16_t* d = (bf16_t*)(ws + W_IN); const float* s = p.in[6]; const float* gn = p.in[5];
        switch (j) {
            case 0: return mkjob(s, 5664, 0, 512, 1024, d, BIG, 0, 0, gn, 0.08838834764831845f);
            case 1: return mkjob(s, 5664, 512, 512, 1024, d, BIG, 0, 512, gn, 1.0f);
            case 2: return mkjob(s, 5664, 1024, 1024, 1024, d, BIG, 0, 1024, gn, 1.0f);
            case 3: return mkjob(s, 5664, 2048, 1024, 1024, d, BIG, 0, 2048, gn, 1.0f);
            case 4: return mkjob(s, 5664, 3072, 16, 1024, d, BIG, 0, 5632, gn, 1.0f);
            case 5: return mkjob(s, 5664, 3088, 1024, 1024, d, BIG, 0, 3072, gn, 1.0f);
            case 6: return mkjob(s, 5664, 4112, 1536, 1024, d, BIG, 0, 4096, gn, 1.0f);
            default: return mkjob(s, 5664, 5648, 16, 1024, d, BIG, 0, 5648, gn, 1.0f);
        } }
    j -= 8;
    if (j == 0) return mkjob(p.in[16], 1024, 0, 1024, 2048, (bf16_t*)(ws + W_OUT), BIG, 0, 0, nullptr, 1.0f);
    j -= 1;
    if (j < 4) { bf16_t* d = (bf16_t*)(ws + W_D1); const float* gn = p.in[5] + 1024;
        switch (j) {
            case 0: return mkjob(p.in[17], 256, 0, 256, 1024, d, BIG, 0, 0, gn, 1.0f);
            case 1: return mkjob(p.in[20], 128, 0, 128, 1024, d, BIG, 0, 256, gn, 1.0f);
            case 2: return mkjob(p.in[25], 64, 0, 64, 1024, d, BIG, 0, 384, gn, 1.0f);
            default: return mkjob(p.in[28], 16, 0, 16, 1024, d, BIG, 0, 448, gn, 1.0f);
        } }
    j -= 4;
    if (j == 0) return mkjob(p.in[19], 2048, 0, 2048, 256, (bf16_t*)(ws + W_D3), BIG, 0, 0, nullptr, 0.08838834764831845f);
    return mkjob(p.in[24], 1024, 0, 1024, 256, (bf16_t*)(ws + W_D3), BIG, 0, 2048, nullptr, 1.0f);
}
constexpr int N_PREP_JOBS = 27;

__device__ void phase_prologue(const Params& p, LAS unsigned char* lds) {
    const int tid = threadIdx.x, wid = tid >> 6, lane = tid & 63;
    { const float* x = p.in[0]; bf16_t* XB = (bf16_t*)(p.ws + WS_XB); float* ss = (float*)(p.ws + WS_SS);
      for (int row = blockIdx.x * 8 + wid; row < T_TOK; row += gridDim.x * 8) {
          float sq = 0.f;
#pragma unroll
          for (int i = 0; i < 4; ++i) { const size_t o = (size_t)row * DM + i * 256 + lane * 4; const f32x4 v = *(const f32x4*)(x + o);
              sq += (v[0] * v[0] + v[1] * v[1]) + (v[2] * v[2] + v[3] * v[3]); u32x2 w; w.x = cvt_pk_bf16(v[0], v[1]); w.y = cvt_pk_bf16(v[2], v[3]); *(u32x2*)(XB + o) = w; }
          sq = wave_sum(sq);
          if (lane < 16) ss[(size_t)row * 16 + lane] = lane == 0 ? sq : 0.f; } }
    LAS bf16_t* Tl = (LAS bf16_t*)lds;
    for (int j = 0; j < N_PREP_JOBS; ++j) { const PrepJob J = get_job(p, j); const int nct = (J.ncols + 63) / 64, nt = (J.K / 64) * nct;
        for (int tile = blockIdx.x; tile < nt; tile += gridDim.x) { const int k0 = (tile / nct) * 64, n0 = (tile % nct) * 64;
#pragma unroll
            for (int i = 0; i < 2; ++i) { const int kl = (tid >> 4) + 32 * i, nl = (tid & 15) * 4;
                if (n0 + nl < J.ncols) { const f32x4 v = *(const f32x4*)(J.src + (size_t)(k0 + kl) * J.src_ld + J.col0 + n0 + nl); const float s = J.scale * (J.gain ? J.gain[k0 + kl] : 1.0f);
                    Tl[(nl + 0) * 72 + kl] = f2bf(v[0] * s); Tl[(nl + 1) * 72 + kl] = f2bf(v[1] * s); Tl[(nl + 2) * 72 + kl] = f2bf(v[2] * s); Tl[(nl + 3) * 72 + kl] = f2bf(v[3] * s); } }
            __syncthreads();
            { const int n = tid >> 3, k8 = (tid & 7) * 8;
              if (n0 + n < J.ncols) { const int jj = n0 + n, dr = (jj / J.grp) * J.grp_stride + J.grp_off + (jj % J.grp);
                  *(u32x4*)(J.dst + (size_t)dr * J.K + k0 + k8) = *(const LAS u32x4*)(Tl + n * 72 + k8); } }
            __syncthreads(); } }
    { u32x4 z = {0u, 0u, 0u, 0u}; u32x4* a = (u32x4*)(p.ws + W_IN + (size_t)5664 * 1024 * 2); const int na = 224 * 1024 * 2 / 16;
      for (int i = blockIdx.x * 512 + tid; i < na; i += gridDim.x * 512) a[i] = z;
      u32x4* b = (u32x4*)(p.ws + W_D1 + (size_t)464 * 1024 * 2); const int nb = 48 * 1024 * 2 / 16;
      for (int i = blockIdx.x * 512 + tid; i < nb; i += gridDim.x * 512) b[i] = z; }
    { const float* wuv = p.in[22]; const float* wo = p.in[23]; bf16_t* WC = (bf16_t*)(p.ws + W_C);
      for (int it = blockIdx.x * 512 + tid; it < 1024 * 256; it += gridDim.x * 512) { const int d = it & 1023, cb = it >> 10, h = cb >> 4, c0 = (cb & 15) * 8;
          float a[8] = {0.f, 0.f, 0.f, 0.f, 0.f, 0.f, 0.f, 0.f};
          for (int e = 0; e < 64; ++e) { const float w = wo[(size_t)(h * 64 + e) * 1024 + d];
#pragma unroll
              for (int i = 0; i < 8; ++i) a[i] += wuv[((size_t)h * 128 + c0 + i) * 64 + e] * w; }
          u32x4 o; o.x = cvt_pk_bf16(a[0], a[1]); o.y = cvt_pk_bf16(a[2], a[3]); o.z = cvt_pk_bf16(a[4], a[5]); o.w = cvt_pk_bf16(a[6], a[7]);
          *(u32x4*)(WC + (size_t)d * 2048 + h * 128 + c0) = o; } }
}

#define MFMA16(a, b, c) __builtin_amdgcn_mfma_f32_16x16x32_bf16((a), (b), (c), 0, 0, 0)
__device__ __forceinline__ bf16x8 frag_row(LAS unsigned char* base, int row0, int stride, int k0, int lane) {
    return *(const LAS bf16x8*)(base + (row0 + (lane & 15)) * stride + (k0 + 8 * (lane >> 4)) * 2); }
__device__ __forceinline__ bf16x8 frag_tr(LAS unsigned char* base, int k0, int stride, int n0, int lane) {
    const int g = lane >> 4, q = (lane & 15) >> 2, pp = lane & 3;
    const unsigned a0 = (unsigned)(size_t)base + (unsigned)((k0 + 8 * g + q) * stride + (n0 + 4 * pp) * 2), a1 = a0 + 4u * (unsigned)stride;
    u16x4 lo, hi;
    asm volatile("ds_read_b64_tr_b16 %0, %2\n\tds_read_b64_tr_b16 %1, %3\n\ts_waitcnt lgkmcnt(0)" : "=&v"(lo), "=&v"(hi) : "v"(a0), "v"(a1) : "memory");
    bf16x8 r; r[0] = (short)lo[0]; r[1] = (short)lo[1]; r[2] = (short)lo[2]; r[3] = (short)lo[3]; r[4] = (short)hi[0]; r[5] = (short)hi[1]; r[6] = (short)hi[2]; r[7] = (short)hi[3]; return r;
}
#define LDS_FENCE() asm volatile("s_waitcnt lgkmcnt(0)" ::: "memory")

constexpr int RS128 = 272, RS64 = 144;
constexpr int SC_QT = 0, SC_KT = 17408, SC_KD = 34816, SC_VV = 52224, SC_AT = 61440, SC_SB = 70656, SC_XS = 89088, SC_MISC = 98304;
__device__ void scan_item(const Params& p, int item, LAS unsigned char* lds) {
    const int tid = threadIdx.x, wid = __builtin_amdgcn_readfirstlane(tid >> 6), lane = tid & 63, r16 = lane & 15, g4 = lane >> 4;
    bf16_t* IN = (bf16_t*)(p.ws + WS_IN); const float* SM = (const float*)(p.ws + WS_SMALL);
    const bool ssd = item >= 128;
    LAS float* misc = (LAS float*)(lds + SC_MISC);
    LAS float* glr = misc;
    LAS float* segs = misc + 1024;
    LAS float* dec = misc + 1536;
    LAS float* dtv = misc + 1664;
    LAS float* acum = misc + 1728;
    LAS float* cw = misc + 1792;
    int b, h = 0, vq = 0, hd = 0, grp = 0;
    if (!ssd) { b = item >> 4; h = (item >> 2) & 3; vq = item & 3; } else { const int id = item - 128; b = id >> 4; hd = id & 15; grp = hd >> 3; }
    const int colV = C_V + h * 256 + vq * 64, colZ = C_Z + hd * 64;
    float w2[16]; float bk = 0.f; float a_neg = 0.f, dtb = 0.f, Dh = 0.f;
    if (!ssd) { const int k = tid & 127;
#pragma unroll
        for (int r = 0; r < 16; ++r) w2[r] = p.in[7][r * 512 + h * 128 + k];
        bk = p.in[8][h * 128 + k];
    } else {
#pragma unroll
        for (int r = 0; r < 16; ++r) w2[r] = 0.f;
        a_neg = -__expf(p.in[13][hd]); dtb = p.in[12][hd]; Dh = p.in[14][hd];
        for (int i = tid; i < 5 * 320; i += 512) { const int kk = i / 320, c = i % 320; const int ch = c < 64 ? hd * 64 + c : (c < 192 ? 1024 + grp * 128 + (c - 64) : 1280 + grp * 128 + (c - 192));
            cw[i] = kk < 4 ? p.in[10][kk * 1536 + ch] : p.in[11][ch]; }
    }
    f32x4 Sacc[4];
#pragma unroll
    for (int i = 0; i < 4; ++i) Sacc[i] = (f32x4){0.f, 0.f, 0.f, 0.f};
    for (int i = tid; i < 128 * RS64 / 4; i += 512) ((LAS unsigned*)(lds + SC_SB))[i] = 0u;
    __syncthreads();

    for (int c = 0; c < 64; ++c) {
        const int t0 = b * SEQ + c * 64;
        if (!ssd) {
            const int k = tid & 127, seg = tid >> 7;
            bf16_t qraw[16], kraw[16];
#pragma unroll
            for (int jj = 0; jj < 16; ++jj) { const size_t o = (size_t)(t0 + seg * 16 + jj) * IN_LD; qraw[jj] = IN[o + C_Q + h * 128 + k]; kraw[jj] = IN[o + C_K + h * 128 + k]; }
            if (tid < 256) *(LAS f32x4*)(glr + (tid >> 2) * 16 + (tid & 3) * 4) = *(const f32x4*)(SM + (size_t)(t0 + (tid >> 2)) * 32 + (tid & 3) * 4);
            { const int row = tid >> 3, ch = tid & 7; *(LAS u32x4*)(lds + SC_VV + row * RS64 + ch * 16) = *(const u32x4*)(IN + (size_t)(t0 + row) * IN_LD + colV + ch * 8); }
            __syncthreads();
            float cs[16]; float run = 0.f;
#pragma unroll
            for (int jj = 0; jj < 16; ++jj) { const LAS f32x4* gp = (const LAS f32x4*)(glr + (seg * 16 + jj) * 16); float x = bk;
#pragma unroll
                for (int q4 = 0; q4 < 4; ++q4) { const f32x4 gv = gp[q4]; x += gv[0] * w2[q4 * 4 + 0] + gv[1] * w2[q4 * 4 + 1] + gv[2] * w2[q4 * 4 + 2] + gv[3] * w2[q4 * 4 + 3]; }
                const float lg = (fminf(x, 0.f) - log1pf(__expf(-fabsf(x)))) * 0.0625f; run += lg; cs[jj] = run; }
            segs[seg * 128 + k] = run;
            __syncthreads();
            float off = 0.f, tot = 0.f;
#pragma unroll
            for (int s = 0; s < 4; ++s) { const float v = segs[s * 128 + k]; tot += v; if (s < seg) off += v; }
#pragma unroll
            for (int jj = 0; jj < 16; ++jj) { const float bc = off + cs[jj], qv = bf2f(qraw[jj]), kv = bf2f(kraw[jj]); const int j = seg * 16 + jj;
                *(LAS bf16_t*)(lds + SC_QT + j * RS128 + k * 2) = f2bf(qv * __expf(bc));
                *(LAS bf16_t*)(lds + SC_KT + j * RS128 + k * 2) = f2bf(kv * __expf(-bc));
                *(LAS bf16_t*)(lds + SC_KD + j * RS128 + k * 2) = f2bf(kv * __expf(tot - bc)); }
            if (seg == 0) dec[k] = __expf(tot);
        } else {
            if (wid == 0) { const float x = SM[(size_t)(t0 + lane) * 32 + 16 + hd] + dtb; const float dt = x > 20.f ? x : log1pf(__expf(x)); float v = a_neg * dt;
#pragma unroll
                for (int o = 1; o < 64; o <<= 1) { const float t = __shfl_up(v, o); if (lane >= o) v += t; }
                dtv[lane] = dt; acum[lane] = v; }
            __syncthreads();
            const float a_last = acum[63];
#pragma unroll
            for (int i = 0; i < 5; ++i) { const int it = tid + 512 * i, t = it / 40, c0 = (it % 40) * 8;
                const int col = c0 < 64 ? C_X + hd * 64 + c0 : (c0 < 192 ? C_B + grp * 128 + (c0 - 64) : C_C + grp * 128 + (c0 - 192));
                float a8[8];
#pragma unroll
                for (int e = 0; e < 8; ++e) a8[e] = cw[4 * 320 + c0 + e];
#pragma unroll
                for (int kk = 0; kk < 4; ++kk) { const int s = c * 64 + t - 3 + kk;
                    if (s >= 0) { const u32x4 rv = *(const u32x4*)(IN + (size_t)(b * SEQ + s) * IN_LD + col);
#pragma unroll
                        for (int e = 0; e < 4; ++e) { const unsigned w = rv[e]; a8[2 * e] += cw[kk * 320 + c0 + 2 * e] * __uint_as_float(w << 16); a8[2 * e + 1] += cw[kk * 320 + c0 + 2 * e + 1] * __uint_as_float(w & 0xffff0000u); } } }
#pragma unroll
                for (int e = 0; e < 8; ++e) a8[e] = silu_f(a8[e]);
                u32x4 o; o.x = cvt_pk_bf16(a8[0], a8[1]); o.y = cvt_pk_bf16(a8[2], a8[3]); o.z = cvt_pk_bf16(a8[4], a8[5]); o.w = cvt_pk_bf16(a8[6], a8[7]);
                if (c0 < 64) { *(LAS u32x4*)(lds + SC_XS + t * RS64 + c0 * 2) = o; const float d = dtv[t];
                    u32x4 o2; o2.x = cvt_pk_bf16(a8[0] * d, a8[1] * d); o2.y = cvt_pk_bf16(a8[2] * d, a8[3] * d); o2.z = cvt_pk_bf16(a8[4] * d, a8[5] * d); o2.w = cvt_pk_bf16(a8[6] * d, a8[7] * d);
                    *(LAS u32x4*)(lds + SC_VV + t * RS64 + c0 * 2) = o2; }
                else if (c0 < 192) { const int n0 = c0 - 64; *(LAS u32x4*)(lds + SC_KT + t * RS128 + n0 * 2) = o; const float d = __expf(a_last - acum[t]);
                    u32x4 o2; o2.x = cvt_pk_bf16(a8[0] * d, a8[1] * d); o2.y = cvt_pk_bf16(a8[2] * d, a8[3] * d); o2.z = cvt_pk_bf16(a8[4] * d, a8[5] * d); o2.w = cvt_pk_bf16(a8[6] * d, a8[7] * d);
                    *(LAS u32x4*)(lds + SC_KD + t * RS128 + n0 * 2) = o2; }
                else { const int n0 = c0 - 192; *(LAS u32x4*)(lds + SC_QT + t * RS128 + n0 * 2) = o; } }
            if (tid < 128) dec[tid] = __expf(a_last);
        }
        __syncthreads();
        const int ti = wid >> 1;
        bf16x8 qa[4];
#pragma unroll
        for (int s = 0; s < 4; ++s) qa[s] = frag_row(lds + SC_QT, ti * 16, RS128, 32 * s, lane);
#pragma unroll
        for (int t2 = 0; t2 < 2; ++t2) { const int tj = (wid & 1) * 2 + t2; f32x4 acc = {0.f, 0.f, 0.f, 0.f};
            if (tj <= ti) {
#pragma unroll
                for (int s = 0; s < 4; ++s) acc = MFMA16(qa[s], frag_row(lds + SC_KT, tj * 16, RS128, 32 * s, lane), acc); }
            const int j = tj * 16 + r16; const float aj = ssd ? acum[j] : 0.f;
#pragma unroll
            for (int jj = 0; jj < 4; ++jj) { const int i = ti * 16 + 4 * g4 + jj; float v = (j <= i) ? acc[jj] : 0.f; if (ssd) v *= __expf(fminf(acum[i] - aj, 0.f));
                *(LAS bf16_t*)(lds + SC_AT + i * RS64 + j * 2) = f2bf(v); } }
        __syncthreads();
#pragma unroll
        for (int t2 = 0; t2 < 2; ++t2) { const int tv = (wid & 1) * 2 + t2; f32x4 aA = {0.f, 0.f, 0.f, 0.f}, aI = {0.f, 0.f, 0.f, 0.f};
#pragma unroll
            for (int ks = 0; ks < 2; ++ks) aA = MFMA16(frag_row(lds + SC_AT, ti * 16, RS64, 32 * ks, lane), frag_tr(lds + SC_VV, 32 * ks, RS64, tv * 16, lane), aA);
#pragma unroll
            for (int ks = 0; ks < 4; ++ks) aI = MFMA16(qa[ks], frag_tr(lds + SC_SB, 32 * ks, RS64, tv * 16, lane), aI);
            const int v = tv * 16 + r16;
#pragma unroll
            for (int jj = 0; jj < 4; ++jj) { const int i = ti * 16 + 4 * g4 + jj;
                if (!ssd) { IN[(size_t)(t0 + i) * IN_LD + colV + v] = f2bf(aA[jj] + aI[jj]); }
                else { const float o = aA[jj] + __expf(acum[i]) * aI[jj]; const size_t zo = (size_t)(t0 + i) * IN_LD + colZ + v; const float zz = bf2f(IN[zo]);
                    const float xs = bf2f(*(const LAS bf16_t*)(lds + SC_XS + i * RS64 + v * 2)); IN[zo] = f2bf((o + Dh * xs) * silu_f(zz)); } } }
#pragma unroll
        for (int tv = 0; tv < 4; ++tv) {
#pragma unroll
            for (int jj = 0; jj < 4; ++jj) Sacc[tv][jj] *= dec[wid * 16 + 4 * g4 + jj];
#pragma unroll
            for (int ks = 0; ks < 2; ++ks) Sacc[tv] = MFMA16(frag_tr(lds + SC_KD, 32 * ks, RS128, wid * 16, lane), frag_tr(lds + SC_VV, 32 * ks, RS64, tv * 16, lane), Sacc[tv]); }
        __syncthreads();
#pragma unroll
        for (int tv = 0; tv < 4; ++tv)
#pragma unroll
            for (int jj = 0; jj < 4; ++jj) *(LAS bf16_t*)(lds + SC_SB + (wid * 16 + 4 * g4 + jj) * RS64 + (tv * 16 + r16) * 2) = f2bf(Sacc[tv][jj]);
    }
    __syncthreads();
}
__device__ void phase_scan(const Params& p, LAS unsigned char* lds) { for (int item = blockIdx.x; item < 256; item += gridDim.x) scan_item(p, item, lds); }

__device__ void phase_mixnorm(const Params& p) {
    const int tid = threadIdx.x, wid = tid >> 6, lane = tid & 63; bf16_t* IN = (bf16_t*)(p.ws + WS_IN);
    const float* gg = p.in[9]; const float* sg = p.in[15];
    for (int row = blockIdx.x * 8 + wid; row < T_TOK; row += gridDim.x * 8) { bf16_t* rp = IN + (size_t)row * IN_LD;
#pragma unroll
        for (int h = 0; h < 4; ++h) { const int j = h * 256 + lane * 4; const u32x2 ov = *(const u32x2*)(rp + C_V + j), rv = *(const u32x2*)(rp + C_R + j);
            float o[4] = {__uint_as_float(ov.x << 16), __uint_as_float(ov.x & 0xffff0000u), __uint_as_float(ov.y << 16), __uint_as_float(ov.y & 0xffff0000u)};
            float rr[4] = {__uint_as_float(rv.x << 16), __uint_as_float(rv.x & 0xffff0000u), __uint_as_float(rv.y << 16), __uint_as_float(rv.y & 0xffff0000u)};
            const float sq = wave_sum((o[0] * o[0] + o[1] * o[1]) + (o[2] * o[2] + o[3] * o[3])); const float rs = rsqrtf(sq * (1.0f / 256.0f) + 1e-6f);
            const f32x4 gv = *(const f32x4*)(gg + j);
            u32x2 w; w.x = cvt_pk_bf16(o[0] * rs * gv[0] * silu_f(rr[0]), o[1] * rs * gv[1] * silu_f(rr[1])); w.y = cvt_pk_bf16(o[2] * rs * gv[2] * silu_f(rr[2]), o[3] * rs * gv[3] * silu_f(rr[3]));
            *(u32x2*)(rp + C_R + j) = w; }
#pragma unroll
        for (int g = 0; g < 2; ++g) { const int j = g * 512 + lane * 8; const u32x4 yv = *(const u32x4*)(rp + C_Z + j); float y[8];
#pragma unroll
            for (int e = 0; e < 4; ++e) { y[2 * e] = __uint_as_float(yv[e] << 16); y[2 * e + 1] = __uint_as_float(yv[e] & 0xffff0000u); }
            float sq = 0.f;
#pragma unroll
            for (int e = 0; e < 8; ++e) sq += y[e] * y[e];
            sq = wave_sum(sq); const float rs = rsqrtf(sq * (1.0f / 512.0f) + 1e-6f);
            const f32x4 g0 = *(const f32x4*)(sg + j), g1 = *(const f32x4*)(sg + j + 4);
            u32x4 w; w.x = cvt_pk_bf16(y[0] * rs * g0[0], y[1] * rs * g0[1]); w.y = cvt_pk_bf16(y[2] * rs * g0[2], y[3] * rs * g0[3]); w.z = cvt_pk_bf16(y[4] * rs * g1[0], y[5] * rs * g1[1]); w.w = cvt_pk_bf16(y[6] * rs * g1[2], y[7] * rs * g1[3]);
            *(u32x4*)(rp + C_Z + j) = w; } }
}

__device__ void phase_d2(const Params& p) {
    const int tid = threadIdx.x, wid = tid >> 6, lane = tid & 63;
    const float* raw = (const float*)(p.ws + WS_RAW1); bf16_t* QL = (bf16_t*)(p.ws + WS_QLAT); bf16_t* KV = (bf16_t*)(p.ws + WS_KV); bf16_t* KI = (bf16_t*)(p.ws + WS_KIDX); float* WI = (float*)(p.ws + WS_WIDX);
    const float* qg = p.in[18]; const float* kg = p.in[21]; const float* lg = p.in[26]; const float* lb = p.in[27];
    for (int row = blockIdx.x * 8 + wid; row < T_TOK; row += gridDim.x * 8) { const float* rp = raw + (size_t)row * 512;
        { const f32x4 v = *(const f32x4*)(rp + lane * 4); const float sq = wave_sum((v[0] * v[0] + v[1] * v[1]) + (v[2] * v[2] + v[3] * v[3])); const float rs = rsqrtf(sq * (1.0f / 256.0f) + 1e-6f);
          const f32x4 g = *(const f32x4*)(qg + lane * 4); u32x2 w; w.x = cvt_pk_bf16(v[0] * rs * g[0], v[1] * rs * g[1]); w.y = cvt_pk_bf16(v[2] * rs * g[2], v[3] * rs * g[3]);
          *(u32x2*)(QL + (size_t)row * 256 + lane * 4) = w; }
        { const float a = rp[256 + lane * 2], b = rp[256 + lane * 2 + 1]; const float sq = wave_sum(a * a + b * b); const float rs = rsqrtf(sq * (1.0f / 128.0f) + 1e-6f);
          *(unsigned*)(KV + (size_t)row * 128 + lane * 2) = cvt_pk_bf16(a * rs * kg[lane * 2], b * rs * kg[lane * 2 + 1]); }
        { const float a = rp[384 + lane]; const float mu = wave_sum(a) * (1.0f / 64.0f); const float d = a - mu; const float var = wave_sum(d * d) * (1.0f / 64.0f);
          KI[(size_t)row * 64 + lane] = f2bf(d * rsqrtf(var + 1e-6f) * lg[lane] + lb[lane]); }
        if (lane < 16) WI[(size_t)row * 16 + lane] = rp[448 + lane] * 0.03125f; }
}

constexpr int DS_LIST = 131072, DS_RELB = 139264, DS_BUCK = 141312;
__device__ __forceinline__ unsigned f2key(float f) { const unsigned u = __float_as_uint(f); return (u & 0x80000000u) ? ~u : (u | 0x80000000u); }
__device__ __forceinline__ int wave_isum(int v) { v += __shfl_xor(v, 32); v += __shfl_xor(v, 16); v += __shfl_xor(v, 8); v += __shfl_xor(v, 4); v += __shfl_xor(v, 2); v += __shfl_xor(v, 1); return v; }
__device__ void phase_dsa(const Params& p, LAS unsigned char* lds) {
    const int tid = threadIdx.x, wid = __builtin_amdgcn_readfirstlane(tid >> 6), lane = tid & 63, r16 = lane & 15, g4 = lane >> 4;
    bf16_t* Q = (bf16_t*)(p.ws + WS_Q); const bf16_t* QI = (const bf16_t*)(p.ws + WS_QIDX); const bf16_t* KV = (const bf16_t*)(p.ws + WS_KV);
    const bf16_t* KI = (const bf16_t*)(p.ws + WS_KIDX); const float* WI = (const float*)(p.ws + WS_WIDX);
    LAS float* relb = (LAS float*)(lds + DS_RELB); LAS int* buck = (LAS int*)(lds + DS_BUCK);
    relb[tid] = p.in[29][tid];
    if (tid < 128) { int bk = tid; if (tid >= 16) { const float relf = (float)tid; int lg = 16 + (int)(logf(relf / 16.0f) / 2.0794415416798357f * 16.0f); bk = lg < 31 ? lg : 31; } buck[tid] = bk; }
    __syncthreads();
    LAS unsigned* myslab = (LAS unsigned*)(lds + wid * 16384);
    LAS unsigned* mylist = (LAS unsigned*)(lds + DS_LIST + wid * 1024);
    LAS unsigned char* kvst = lds + wid * 16384;
    LAS unsigned char* pst = lds + wid * 16384 + 8704;
    for (int u = blockIdx.x; u < 4096; u += gridDim.x) {
        const int ui = u >> 8, ublk = u & 255, b = ublk & 7, xx = ublk >> 3, ti = ui * 32 + ((ui & 1) ? 31 - xx : xx);
        const int q0 = ti * 8, tok0 = b * SEQ + q0, nkt = (q0 + 8 + 15) >> 4, n16 = nkt * 16;
        {
            bf16x8 qa[8][2]; f32x4 wq[8];
#pragma unroll
            for (int qq = 0; qq < 8; ++qq) { const bf16_t* qp = QI + (size_t)(tok0 + qq) * 1024 + r16 * 64 + 8 * g4;
                qa[qq][0] = *(const bf16x8*)qp; qa[qq][1] = *(const bf16x8*)(qp + 32); wq[qq] = *(const f32x4*)(WI + (size_t)(tok0 + qq) * 16 + 4 * g4); }
            bf16x8 kb0, kb1;
            if (wid < nkt) { const bf16_t* kp = KI + (size_t)(b * SEQ + wid * 16 + r16) * 64 + 8 * g4; kb0 = *(const bf16x8*)kp; kb1 = *(const bf16x8*)(kp + 32); }
            for (int kt = wid; kt < nkt; kt += 8) {
                const bf16x8 c0 = kb0, c1 = kb1;
                if (kt + 8 < nkt) { const bf16_t* kp = KI + (size_t)(b * SEQ + (kt + 8) * 16 + r16) * 64 + 8 * g4; kb0 = *(const bf16x8*)kp; kb1 = *(const bf16x8*)(kp + 32); }
                const int key = kt * 16 + r16;
#pragma unroll
                for (int qq = 0; qq < 8; ++qq) { f32x4 acc = {0.f, 0.f, 0.f, 0.f}; acc = MFMA16(qa[qq][0], c0, acc); acc = MFMA16(qa[qq][1], c1, acc);
                    float s = wq[qq][0] * fmaxf(acc[0], 0.f) + wq[qq][1] * fmaxf(acc[1], 0.f) + wq[qq][2] * fmaxf(acc[2], 0.f) + wq[qq][3] * fmaxf(acc[3], 0.f);
                    s += __shfl_xor(s, 16); s += __shfl_xor(s, 32);
                    if (g4 == 0) ((LAS unsigned*)(lds + qq * 16384))[key] = (key <= q0 + qq) ? f2key(s + 0.0f) : 0u; }
            }
        }
        __syncthreads();
        const int qpos = q0 + wid, n = qpos + 1; int nsel;
        if (n <= 256) { nsel = n; for (int i = lane; i < n; i += 64) mylist[i] = (unsigned)i; }
        else {
            unsigned thr = 0u;
            for (int bit = 31; bit >= 0; --bit) { const unsigned trial = thr | (1u << bit); int cnt = 0;
                for (int base = lane * 4; base < n16; base += 256) { const u32x4 v = *(const LAS u32x4*)(myslab + base); cnt += (int)(v[0] >= trial) + (int)(v[1] >= trial) + (int)(v[2] >= trial) + (int)(v[3] >= trial); }
                cnt = wave_isum(cnt);
                if (cnt >= 256) thr = trial;
                if (cnt == 256) break; }
            int cgt = 0;
            for (int base = lane * 4; base < n16; base += 256) { const u32x4 v = *(const LAS u32x4*)(myslab + base); cgt += (int)(v[0] > thr) + (int)(v[1] > thr) + (int)(v[2] > thr) + (int)(v[3] > thr); }
            cgt = wave_isum(cgt);
            const int need_eq = 256 - cgt; int nout = 0, eq_seen = 0;
            for (int base = 0; base < n16; base += 64) { const unsigned kv = myslab[base + lane]; const bool gt = kv > thr, eq = kv == thr;
                const unsigned long long eqm = __ballot(eq); const unsigned long long lt = (1ull << lane) - 1ull;
                const bool sel = gt || (eq && (eq_seen + __popcll(eqm & lt)) < need_eq);
                const unsigned long long sm = __ballot(sel); const int pos = nout + __popcll(sm & lt);
                if (sel && pos < 256) mylist[pos] = (unsigned)(base + lane);
                nout += __popcll(sm); eq_seen += __popcll(eqm); }
            nsel = 256;
        }
        LDS_FENCE();
        {
            const int tq = tok0 + wid; bf16x8 qf[4];
#pragma unroll
            for (int s = 0; s < 4; ++s) qf[s] = *(const bf16x8*)(Q + (size_t)tq * 2048 + r16 * 128 + 32 * s + 8 * g4);
            f32x4 O[8]; float mrun[4], lrun[4];
#pragma unroll
            for (int i = 0; i < 8; ++i) O[i] = (f32x4){0.f, 0.f, 0.f, 0.f};
#pragma unroll
            for (int i = 0; i < 4; ++i) { mrun[i] = -INFINITY; lrun[i] = 0.f; }
            const int nch = (nsel + 31) >> 5;
            u32x4 gbuf[8];
#pragma unroll
            for (int i = 0; i < 8; ++i) { const int piece = lane + 64 * i, row = piece >> 4, c16 = piece & 15; const int kidx = row < nsel ? (int)mylist[row] : 0;
                gbuf[i] = *(const u32x4*)(KV + (size_t)(b * SEQ + kidx) * 128 + c16 * 8); }
            for (int ch = 0; ch < nch; ++ch) {
#pragma unroll
                for (int i = 0; i < 8; ++i) { const int piece = lane + 64 * i, row = piece >> 4, c16 = piece & 15; *(LAS u32x4*)(kvst + row * 272 + c16 * 16) = gbuf[i]; }
                if (ch + 1 < nch) {
#pragma unroll
                    for (int i = 0; i < 8; ++i) { const int piece = lane + 64 * i, row = (ch + 1) * 32 + (piece >> 4), c16 = piece & 15; const int kidx = row < nsel ? (int)mylist[row] : 0;
                        gbuf[i] = *(const u32x4*)(KV + (size_t)(b * SEQ + kidx) * 128 + c16 * 8); } }
                LDS_FENCE();
                f32x4 S[2];
#pragma unroll
                for (int t2 = 0; t2 < 2; ++t2) { f32x4 acc = {0.f, 0.f, 0.f, 0.f};
#pragma unroll
                    for (int s = 0; s < 4; ++s) acc = MFMA16(qf[s], frag_row(kvst, t2 * 16, 272, 32 * s, lane), acc);
                    const int kk = ch * 32 + t2 * 16 + r16; const bool valid = kk < nsel; const int skey = valid ? (int)mylist[kk] : 0; const int rel = qpos - skey;
                    const int bk = rel < 128 ? buck[rel < 0 ? 0 : rel] : 31; const f32x4 bias = *(const LAS f32x4*)(relb + bk * 16 + 4 * g4);
#pragma unroll
                    for (int jj = 0; jj < 4; ++jj) S[t2][jj] = valid ? acc[jj] + bias[jj] : -INFINITY; }
                float alpha[4];
#pragma unroll
                for (int jj = 0; jj < 4; ++jj) { float cm = fmaxf(S[0][jj], S[1][jj]); cm = fmaxf(cm, __shfl_xor(cm, 1)); cm = fmaxf(cm, __shfl_xor(cm, 2)); cm = fmaxf(cm, __shfl_xor(cm, 4)); cm = fmaxf(cm, __shfl_xor(cm, 8));
                    const float mn = fmaxf(mrun[jj], cm); alpha[jj] = __expf(mrun[jj] - mn); mrun[jj] = mn;
                    const float p0 = __expf(S[0][jj] - mn), p1 = __expf(S[1][jj] - mn); lrun[jj] = lrun[jj] * alpha[jj] + p0 + p1;
                    *(LAS bf16_t*)(pst + (4 * g4 + jj) * 80 + r16 * 2) = f2bf(p0); *(LAS bf16_t*)(pst + (4 * g4 + jj) * 80 + (16 + r16) * 2) = f2bf(p1); }
                LDS_FENCE();
                const bf16x8 pa = *(const LAS bf16x8*)(pst + r16 * 80 + g4 * 16);
#pragma unroll
                for (int ct = 0; ct < 8; ++ct) {
#pragma unroll
                    for (int jj = 0; jj < 4; ++jj) O[ct][jj] *= alpha[jj];
                    O[ct] = MFMA16(pa, frag_tr(kvst, 0, 272, ct * 16, lane), O[ct]); }
            }
#pragma unroll
            for (int jj = 0; jj < 4; ++jj) { float l = lrun[jj]; l += __shfl_xor(l, 1); l += __shfl_xor(l, 2); l += __shfl_xor(l, 4); l += __shfl_xor(l, 8); const float inv = 1.0f / l;
#pragma unroll
                for (int ct = 0; ct < 8; ++ct) Q[(size_t)tq * 2048 + (4 * g4 + jj) * 128 + ct * 16 + r16] = f2bf(O[ct][jj] * inv); }
        }
        __syncthreads();
    }
}

__device__ void phase_final(const Params& p) {
    const float* ss = (const float*)(p.ws + WS_SS); const float* g = p.in[30]; float* X = p.out;
    for (size_t i = (size_t)blockIdx.x * 512 + threadIdx.x; i < (size_t)T_TOK * 256; i += (size_t)gridDim.x * 512) { const int row = (int)(i >> 8), c = (int)(i & 255) * 4;
        const float rs = row_rstd(ss, row); const f32x4 v = *(const f32x4*)(X + (size_t)row * DM + c), gv = *(const f32x4*)(g + c);
        *(f32x4*)(X + (size_t)row * DM + c) = v * rs * gv; }
}

constexpr int N_PHASES = 19;
__global__ void __launch_bounds__(512, 2) fwd_mega(Params p) {
    extern __shared__ __attribute__((aligned(16))) unsigned char shm[];
    LAS unsigned char* lds = (LAS unsigned char*)shm;
    cg::grid_group grid = cg::this_grid();
    unsigned char* ws = p.ws;
    bf16_t* XB = (bf16_t*)(ws + WS_XB); float* SS = (float*)(ws + WS_SS); bf16_t* ACT = (bf16_t*)(ws + WS_ACT); bf16_t* IN = (bf16_t*)(ws + WS_IN);
#ifndef KEEPMASK
#define KEEPMASK 0xFFFFFFFFu
#endif
#define PHASE(n, ...) if (((KEEPMASK >> (n)) & 1u) && p.ph_lo <= (n) && (n) < p.ph_hi) { __VA_ARGS__; if ((n) + 1 < p.ph_hi) grid.sync(); }
#define GU_PHASE(n, lf) PHASE(n, { EpiGU E; E.act = ACT; E.ss = SS; run_gemm(lds, XB, 1024, (const bf16_t*)(ws + W_GU + (lf) * W_GU_SZ), T_TOK, 5632, 1024, E); })
#define DN_PHASE(n, lf, RES) PHASE(n, { EpiRes E; E.res = (RES); E.X = p.out; E.XB = XB; E.ss = SS; run_gemm(lds, ACT, 2816, (const bf16_t*)(ws + W_D + (lf) * W_D_SZ), T_TOK, 1024, 2816, E); })
    PHASE(0, phase_prologue(p, lds))
    GU_PHASE(1, 0)
    DN_PHASE(2, 0, p.in[0])
    PHASE(3, { EpiIn E; E.IN = IN; E.small = (float*)(ws + WS_SMALL); E.ss = SS; run_gemm(lds, XB, 1024, (const bf16_t*)(ws + W_IN), T_TOK, 5888, 1024, E); })
    PHASE(4, phase_scan(p, lds))
    PHASE(5, phase_mixnorm(p))
    PHASE(6, { EpiRes E; E.res = p.out; E.X = p.out; E.XB = XB; E.ss = SS; run_gemm(lds, IN + C_R, IN_LD, (const bf16_t*)(ws + W_OUT), T_TOK, 1024, 2048, E); })
    GU_PHASE(7, 1)
    DN_PHASE(8, 1, p.out)
    GU_PHASE(9, 2)
    DN_PHASE(10, 2, p.out)
    PHASE(11, { EpiD1 E; E.raw = (float*)(ws + WS_RAW1); E.ss = SS; run_gemm(lds, XB, 1024, (const bf16_t*)(ws + W_D1), T_TOK, 512, 1024, E); })
    PHASE(12, phase_d2(p))
    PHASE(13, { EpiD3 E; E.Q = (bf16_t*)(ws + WS_Q); E.QI = (bf16_t*)(ws + WS_QIDX); run_gemm(lds, (const bf16_t*)(ws + WS_QLAT), 256, (const bf16_t*)(ws + W_D3), T_TOK, 3072, 256, E); })
    PHASE(14, phase_dsa(p, lds))
    PHASE(15, { EpiRes E; E.res = p.out; E.X = p.out; E.XB = XB; E.ss = SS; run_gemm(lds, (const bf16_t*)(ws + WS_Q), 2048, (const bf16_t*)(ws + W_C), T_TOK, 1024, 2048, E); })
    GU_PHASE(16, 3)
    DN_PHASE(17, 3, p.out)
    PHASE(18, phase_final(p))
}

extern "C" void kernel_launch(void* const* d_in, const int* in_sizes, int n_in, void* d_out, int out_size, void* d_ws, size_t ws_size, hipStream_t stream) {
    static int grid = 0;
    if (grid == 0) {
        int dev = 0, cus = 0, per_cu = 0;
        hipGetDevice(&dev); hipDeviceGetAttribute(&cus, hipDeviceAttributeMultiprocessorCount, dev);
        hipFuncSetAttribute((const void*)fwd_mega, hipFuncAttributeMaxDynamicSharedMemorySize, LDS_BYTES);
        hipOccupancyMaxActiveBlocksPerMultiprocessor(&per_cu, (const void*)fwd_mega, 512, LDS_BYTES);
        (void)hipGetLastError();
        if (per_cu < 1) per_cu = 1;
        grid = cus > 0 ? cus : 256;
        if (n_in != 31 || ws_size < WS_END) fprintf(stderr, "kernel_launch: unexpected n_in %d / ws_size %zu (need %zu)\n", n_in, ws_size, (size_t)WS_END);
    }
    Params p{};
    for (int i = 0; i < 31; ++i) p.in[i] = (const float*)d_in[i];
    p.out = (float*)d_out; p.ws = (unsigned char*)d_ws; p.ph_lo = 0; p.ph_hi = N_PHASES;
    void* args[] = {&p};
    hipError_t e = hipLaunchCooperativeKernel((const void*)fwd_mega, dim3(grid), dim3(512), args, LDS_BYTES, stream);
    if (e != hipSuccess) fprintf(stderr, "cooperative launch failed: %s (grid %d)\n", hipGetErrorString(e), grid);
}
```

```cpp
#include <hip/hip_runtime.h>
#include <hip/hip_cooperative_groups.h>
#include <cstdio>
#include <cstdint>
namespace cg = cooperative_groups;

#include <hip/hip_runtime.h>
namespace pg8 {
#define PG8_LAS __attribute__((address_space(3)))
typedef unsigned short bf16_t;
typedef short bf16x8 __attribute__((ext_vector_type(8)));
typedef float f32x4 __attribute__((ext_vector_type(4)));
typedef unsigned u32x4 __attribute__((ext_vector_type(4)));
constexpr int BM = 256, BK = 64, HALF = 128, HTB = HALF * BK * 2  , STAGE_BYTES = 8 * HTB, NXCD = 8, WGM = 8;

__host__ __device__ __forceinline__ int lds_byte(int r, int c) { const int st = (r >> 4) * 2 + (c >> 5), rr = r & 15, cc = c & 31, ob = rr * 64 + cc * 2; return st * 1024 + (ob ^ (((ob >> 9) & 1) << 5)); }
__host__ __device__ __forceinline__ void stage_rc(int b, int& R, int& C) { const int st = b / 1024, sb = b % 1024, swz = sb ^ (((sb >> 9) & 1) << 5); R = (st >> 1) * 16 + swz / 64; C = (st & 1) * 32 + (swz % 64) / 2; }
__host__ __device__ __forceinline__ int perm32(int rho) { const int n = rho >> 4, i = rho & 15; return 8 * (i >> 2) + 4 * n + (i & 3); }

struct Unit { int pm, pn; };
struct Gemm { const bf16_t* A; const bf16_t* Bt; int M, N, K, lda; };

struct StaticOrder {
    int nM, nN, nwg, G, c, wgm;
    __host__ __device__ void init(int M, int N, int G_, int c_, int wgm_ = WGM) { nM = M / BM; nN = N / BM; nwg = nM * nN; G = G_; c = c_; wgm = wgm_; }
    __host__ __device__ bool next(int i, Unit& u) const {
        const long L = (long)i * G + c; if (L >= nwg) return false;
        int wgid = (int)L; { const int q = nwg / NXCD, r = nwg % NXCD, xcd = wgid % NXCD, off = wgid / NXCD; wgid = (xcd < r ? xcd * (q + 1) : r * (q + 1) + (xcd - r) * q) + off; }
        const int nig = wgm * nN, gid = wgid / nig, fm = gid * wgm, gsz = (nM - fm) < wgm ? (nM - fm) : wgm;
        u.pm = fm + ((wgid % nig) % gsz); u.pn = (wgid % nig) / gsz; return true;
    }
    __device__ __forceinline__ void a_ready(const Unit&) const {}
    __device__ __forceinline__ void done(const Unit&) const {}
};

typedef __bf16 bf16n2 __attribute__((ext_vector_type(2))); typedef float f32n2 __attribute__((ext_vector_type(2)));
__device__ __forceinline__ unsigned cvt_pk_bf16(float lo, float hi) { const bf16n2 h = __builtin_convertvector((f32n2){lo, hi}, bf16n2); return __builtin_bit_cast(unsigned, h); }

template <class Epi, class Sched>
__device__ __forceinline__ void gemm_phase(PG8_LAS unsigned char* lds, const Gemm g, const Sched& S, const Epi& E) {
    const int tid = threadIdx.x, wid = __builtin_amdgcn_readfirstlane(tid >> 6), lane = tid & 63, wr = wid >> 2, wc = wid & 3, fr = lane & 15, fq = lane >> 4;
    const int K = g.K, nt = K / BK;
    unsigned voffA[2], voffB[2];
#pragma unroll
    for (int i = 0; i < 2; ++i) { int R, C; stage_rc(tid * 16 + i * 8192, R, C); const int Rb = Epi::PERM ? ((R & ~31) + perm32(R & 31)) : R;
        voffA[i] = (unsigned)(R * g.lda + C) * 2u; voffB[i] = (unsigned)(Rb * K + C) * 2u; }
    const size_t kstep = (size_t)(BK * 2);
    const size_t hstep = (size_t)HALF * K * 2;
    const size_t hstepA = (size_t)HALF * g.lda * 2, tstepA = 2 * hstepA;
    const size_t tstep = 2 * hstep;
    const unsigned ldsw = (unsigned)wid * 1024u;
    const int aoff = lds_byte(wr * 64 + fr, fq * 8), boff = lds_byte(wc * 32 + fr, fq * 8);
#define PG8_SA(b, h) (((b) * 2 + (h)) * HTB)
#define PG8_SB(b, h) ((4 + (b) * 2 + (h)) * HTB)
#define PG8_STAGE(bufoff, gbase, voff) do { _Pragma("unroll") for (int _i = 0; _i < 2; ++_i) \
        __builtin_amdgcn_global_load_lds((const unsigned*)((const char*)(gbase) + (voff)[_i]), (PG8_LAS unsigned*)(lds + (bufoff) + ldsw + _i * 8192), 16, 0, 0); } while (0)
#define PG8_LDA(dst, b, h) do { _Pragma("unroll") for (int m = 0; m < 4; ++m) _Pragma("unroll") for (int k = 0; k < 2; ++k) dst[m][k] = *(const PG8_LAS bf16x8*)(lds + PG8_SA(b, h) + aoff + m * 2048 + k * 1024); } while (0)
#define PG8_LDB(dst, b, h) do { _Pragma("unroll") for (int n = 0; n < 2; ++n) _Pragma("unroll") for (int k = 0; k < 2; ++k) dst[n][k] = *(const PG8_LAS bf16x8*)(lds + PG8_SB(b, h) + boff + n * 2048 + k * 1024); } while (0)
#define PG8_MMA(ai, bj, At, Bt) do { __builtin_amdgcn_s_setprio(1); _Pragma("unroll") for (int m = 0; m < 4; ++m) _Pragma("unroll") for (int n = 0; n < 2; ++n) _Pragma("unroll") for (int k = 0; k < 2; ++k) \
        acc[ai][bj][m][n] = __builtin_amdgcn_mfma_f32_16x16x32_bf16(Bt[n][k], At[m][k], acc[ai][bj][m][n], 0, 0, 0); __builtin_amdgcn_s_setprio(0); } while (0)
#define PG8_WAIT_V(n) asm volatile("s_waitcnt vmcnt(" #n ")" ::: "memory")
#define PG8_WAIT_L(n) asm volatile("s_waitcnt lgkmcnt(" #n ")" ::: "memory")
#define PG8_BAR __builtin_amdgcn_s_barrier()
#define PG8_SCHED __builtin_amdgcn_sched_barrier(0)
    Unit cur, nxt; int ui = 0;
    if (!S.next(0, cur)) return;
    f32x4 acc[2][2][4][2];
#pragma unroll
    for (int a = 0; a < 2; ++a)
#pragma unroll
        for (int b = 0; b < 2; ++b)
#pragma unroll
            for (int m = 0; m < 4; ++m)
#pragma unroll
                for (int n = 0; n < 2; ++n) acc[a][b][m][n] = (f32x4){0.f, 0.f, 0.f, 0.f};
    bf16x8 At[4][2], B0[2][2], B1[2][2];
    const char* cA = (const char*)g.A + (size_t)cur.pm * tstepA; const char* cB = (const char*)g.Bt + (size_t)cur.pn * tstep;
    S.a_ready(cur);
    PG8_STAGE(PG8_SB(0, 0), cB, voffB); PG8_STAGE(PG8_SA(0, 0), cA, voffA); PG8_STAGE(PG8_SB(0, 1), cB + hstep, voffB); PG8_STAGE(PG8_SA(0, 1), cA + hstepA, voffA);
    if (wr == 1) PG8_BAR;
    PG8_WAIT_V(4); PG8_BAR;
    PG8_STAGE(PG8_SB(1, 0), cB + kstep, voffB); PG8_STAGE(PG8_SA(1, 0), cA + kstep, voffA); PG8_STAGE(PG8_SB(1, 1), cB + hstep + kstep, voffB);
    PG8_WAIT_V(6); PG8_BAR;
    for (;;) {
        const bool has_next = S.next(ui + 1, nxt);
        const char* nA = has_next ? (const char*)g.A + (size_t)nxt.pm * tstepA : cA; const char* nB = has_next ? (const char*)g.Bt + (size_t)nxt.pn * tstep : cB;
        for (int t = 0; t < nt; t += 2) {
            const bool last = (t == nt - 2);
            const char* a1 = cA + (size_t)(t + 1) * kstep;
            const char* a2 = last ? nA : cA + (size_t)(t + 2) * kstep; const char* b2 = last ? nB : cB + (size_t)(t + 2) * kstep;
            const char* a3 = a2 + kstep; const char* b3 = b2 + kstep;
            if (last && has_next) S.a_ready(nxt);
            PG8_LDB(B0, 0, 0); PG8_SCHED; PG8_LDA(At, 0, 0); PG8_STAGE(PG8_SA(1, 1), a1 + hstepA, voffA);
            PG8_WAIT_L(8); PG8_BAR; PG8_WAIT_L(0); PG8_MMA(0, 0, At, B0); PG8_BAR; PG8_SCHED;
            PG8_LDB(B1, 0, 1); PG8_STAGE(PG8_SB(0, 0), b2, voffB);
            PG8_BAR; PG8_WAIT_L(0); PG8_MMA(0, 1, At, B1); PG8_BAR;
            PG8_LDA(At, 0, 1); PG8_STAGE(PG8_SA(0, 0), a2, voffA);
            PG8_BAR; PG8_WAIT_L(0); PG8_MMA(1, 0, At, B0); PG8_BAR; PG8_SCHED;
            PG8_STAGE(PG8_SB(0, 1), b2 + hstep, voffB);
            PG8_WAIT_V(6); PG8_BAR; PG8_MMA(1, 1, At, B1); PG8_BAR;
            PG8_LDB(B0, 1, 0); PG8_SCHED; PG8_LDA(At, 1, 0); PG8_STAGE(PG8_SA(0, 1), a2 + hstepA, voffA);
            PG8_WAIT_L(8); PG8_BAR; PG8_WAIT_L(0); PG8_MMA(0, 0, At, B0); PG8_BAR; PG8_SCHED;
            PG8_LDB(B1, 1, 1); PG8_STAGE(PG8_SB(1, 0), b3, voffB);
            PG8_BAR; PG8_WAIT_L(0); PG8_MMA(0, 1, At, B1); PG8_BAR;
            PG8_LDA(At, 1, 1); PG8_STAGE(PG8_SA(1, 0), a3, voffA);
            PG8_BAR; PG8_WAIT_L(0); PG8_MMA(1, 0, At, B0); PG8_BAR; PG8_SCHED;
            PG8_STAGE(PG8_SB(1, 1), b3 + hstep, voffB);
            PG8_WAIT_V(6); PG8_BAR; PG8_MMA(1, 1, At, B1); PG8_BAR;
        }
        if constexpr (!Epi::AFTER_DRAIN) { E(acc, cur, wr, wc, fr, fq); S.done(cur); }
        if (!has_next) break;
#pragma unroll
        for (int a = 0; a < 2; ++a)
#pragma unroll
            for (int b = 0; b < 2; ++b)
#pragma unroll
                for (int m = 0; m < 4; ++m)
#pragma unroll
                    for (int n = 0; n < 2; ++n) acc[a][b][m][n] = (f32x4){0.f, 0.f, 0.f, 0.f};
        cur = nxt; cA = nA; cB = nB; ++ui;
    }
    PG8_WAIT_V(0);
    if (wr == 0) PG8_BAR;
    PG8_BAR;
    if constexpr (Epi::AFTER_DRAIN) { E.fused(acc, cur, wr, wc, fr, fq, lds, wid, lane); S.done(cur); }
#undef PG8_SA
#undef PG8_SB
#undef PG8_STAGE
#undef PG8_LDA
#undef PG8_LDB
#undef PG8_MMA
#undef PG8_WAIT_V
#undef PG8_WAIT_L
#undef PG8_BAR
#undef PG8_SCHED
}
}

using pg8::bf16_t; using pg8::bf16x8; using pg8::f32x4; using pg8::u32x4; using pg8::cvt_pk_bf16;
#define LAS __attribute__((address_space(3)))
typedef unsigned short u16x4 __attribute__((ext_vector_type(4)));
typedef unsigned u32x2 __attribute__((ext_vector_type(2)));

constexpr int T_TOK = 32768, SEQ = 4096, DM = 1024, DFF = 2816;
constexpr int IN_LD = 5632;
constexpr int C_Q = 0, C_K = 512, C_V = 1024, C_R = 2048, C_Z = 3072, C_X = 4096, C_B = 5120, C_C = 5376;
constexpr size_t MiB = 1024 * 1024;
constexpr size_t WS_IN = 0;
constexpr size_t WS_ACT = 0;
constexpr size_t WS_Q = 0;
constexpr size_t WS_QIDX = 128 * MiB;
constexpr size_t WS_RAW1 = 192 * MiB;
constexpr size_t WS_OLAT = 192 * MiB;
constexpr size_t WS_QLAT = 320 * MiB;
constexpr size_t WS_KV = 336 * MiB;
constexpr size_t WS_KIDX = 344 * MiB;
constexpr size_t WS_WIDX = 348 * MiB;
constexpr size_t WS_XB = 352 * MiB;
constexpr size_t WS_SS = 416 * MiB;
constexpr size_t WS_SMALL = 418 * MiB;
constexpr size_t WS_W = 422 * MiB;
constexpr size_t W_GU = WS_W;
constexpr size_t W_GU_SZ = (size_t)5632 * 1024 * 2;
constexpr size_t W_D = W_GU + 4 * W_GU_SZ;
constexpr size_t W_D_SZ = (size_t)1024 * 2816 * 2;
constexpr size_t W_IN = W_D + 4 * W_D_SZ;
constexpr size_t W_OUT = W_IN + (size_t)5888 * 1024 * 2;
constexpr size_t W_D1 = W_OUT + (size_t)1024 * 2048 * 2;
constexpr size_t W_D3 = W_D1 + (size_t)512 * 1024 * 2;
constexpr size_t W_C = W_D3 + (size_t)3072 * 256 * 2;
constexpr size_t WS_END = W_C + (size_t)1024 * 2048 * 2;
constexpr size_t WS_BAR = 511 * MiB;
static_assert(WS_END <= WS_BAR, "workspace");
constexpr int LDS_BYTES = 163840;

struct Params { const float* in[31]; float* out; unsigned char* ws; int ph_lo, ph_hi, flags, pad; };

typedef const __attribute__((address_space(4))) char* kptr_t;
__device__ __forceinline__ kptr_t kargs() { kptr_t ka = (kptr_t)__builtin_amdgcn_kernarg_segment_ptr(); asm volatile("" : "+s"(ka)); return ka; }
#define PIN(i) (*(const float* const __attribute__((address_space(4)))*)(kargs() + 8 * (i)))
#define POUT (*(float* const __attribute__((address_space(4)))*)(kargs() + 248))
#define PWS (*(unsigned char* const __attribute__((address_space(4)))*)(kargs() + 256))
#define PARG_I(off) (*(const int __attribute__((address_space(4)))*)(kargs() + (off)))
__device__ __forceinline__ float bf2f(bf16_t v) { return __uint_as_float(((unsigned)v) << 16); }
__device__ __forceinline__ bf16_t f2bf(float f) { return __builtin_bit_cast(bf16_t, (__bf16)f); }
__device__ __forceinline__ float wave_sum(float v) {
#define WS_DPP(x, ctrl) __builtin_bit_cast(float, __builtin_amdgcn_update_dpp(0, __builtin_bit_cast(int, (x)), (ctrl), 0xF, 0xF, true))
    v += WS_DPP(v, 0xB1); v += WS_DPP(v, 0x4E); v += WS_DPP(v, 0x141); v += WS_DPP(v, 0x140);
#undef WS_DPP
    { const unsigned u = __float_as_uint(v); const auto r = __builtin_amdgcn_permlane16_swap(u, u, false, false); v = __uint_as_float(r[0]) + __uint_as_float(r[1]); }
    { const unsigned u = __float_as_uint(v); const auto r = __builtin_amdgcn_permlane32_swap(u, u, false, false); v = __uint_as_float(r[0]) + __uint_as_float(r[1]); }
    return v; }
__device__ __forceinline__ float silu_f(float x) { return x * __builtin_amdgcn_rcpf(1.0f + __builtin_amdgcn_exp2f(x * -1.4426950408889634f)); }
__device__ __forceinline__ float row_rstd(const float* ss, int row) {
    const f32x4* p = (const f32x4*)(ss + (size_t)row * 16); const f32x4 a = p[0], b = p[1], c = p[2], d = p[3];
    const float s = (((a[0] + a[1]) + (a[2] + a[3])) + ((b[0] + b[1]) + (b[2] + b[3]))) + (((c[0] + c[1]) + (c[2] + c[3])) + ((d[0] + d[1]) + (d[2] + d[3])));
    return rsqrtf(s * (1.0f / 1024.0f) + 1e-6f);
}

__device__ __forceinline__ void rows_rstd(const float* ss, int row0, float (&rs)[8]) {
#pragma unroll
    for (int hf = 0; hf < 2; ++hf) {
        f32x4 t[4][4];
#pragma unroll
        for (int i = 0; i < 4; ++i) { const f32x4* p = (const f32x4*)(ss + (size_t)(row0 + hf * 128 + i * 16) * 16);
#pragma unroll
            for (int q = 0; q < 4; ++q) t[i][q] = p[q]; }
#pragma unroll
        for (int i = 0; i < 4; ++i) { const f32x4 a = t[i][0] + t[i][1], b = t[i][2] + t[i][3]; const f32x4 c = a + b; rs[hf * 4 + i] = rsqrtf(((c[0] + c[1]) + (c[2] + c[3])) * (1.0f / 1024.0f) + 1e-6f); }
        asm volatile("" ::: "memory");
    }
}
constexpr int RSTD_TAB = 131072 + 8192;
__device__ __forceinline__ void rows_rstd_cached(const float* ss, int pm, int wr, int wc, int fr, int& cpm, float (&rs)[8]) {
    LAS float* tab = (LAS float*)((LAS unsigned char*)0 + RSTD_TAB) + (wr * 4 + wc) * 128;
    if (pm != cpm) { cpm = pm; const int lane = threadIdx.x & 63;
        f32x4 t[2][4];
#pragma unroll
        for (int h = 0; h < 2; ++h) { const f32x4* p = (const f32x4*)(ss + (size_t)(pm * 256 + h * 128 + wr * 64 + lane) * 16);
#pragma unroll
            for (int q = 0; q < 4; ++q) t[h][q] = p[q]; }
#pragma unroll
        for (int h = 0; h < 2; ++h) { const f32x4 a = t[h][0] + t[h][1], b = t[h][2] + t[h][3]; const f32x4 c = a + b; tab[h * 64 + lane] = rsqrtf(((c[0] + c[1]) + (c[2] + c[3])) * (1.0f / 1024.0f) + 1e-6f); }
        asm volatile("s_waitcnt lgkmcnt(0)" ::: "memory"); }
#pragma unroll
    for (int i = 0; i < 8; ++i) rs[i] = tab[(i >> 2) * 64 + (i & 3) * 16 + fr];
}
struct EpiGU {
    static constexpr bool PERM = true, AFTER_DRAIN = false;
    bf16_t* act; const float* ss; mutable int cpm;
    __device__ __forceinline__ void operator()(const f32x4 (&acc)[2][2][4][2], const pg8::Unit& u, int wr, int wc, int fr, int fq) const {
        const int row0 = u.pm * 256 + wr * 64 + fr, col0 = u.pn * 128 + wc * 32 + 8 * fq;
        float rsv[8]; rows_rstd_cached(ss, u.pm, wr, wc, fr, cpm, rsv);
#pragma unroll
        for (int ai = 0; ai < 2; ++ai)
#pragma unroll
            for (int m = 0; m < 4; ++m) { const int r = row0 + ai * 128 + m * 16; const float rs = rsv[ai * 4 + m];
                const float ea = rs * -1.4426950408889634f, r2 = rs * rs;
                float o[8];
#pragma unroll
                for (int n = 0; n < 2; ++n) { const f32x4 gv = acc[ai][0][m][n], uv = acc[ai][1][m][n]; const f32x4 xa = gv * ea, pu = (gv * uv) * r2; f32x4 rc;
#pragma unroll
                    for (int e = 0; e < 4; ++e) rc[e] = __builtin_amdgcn_rcpf(1.0f + __builtin_amdgcn_exp2f(xa[e]));
                    const f32x4 ov = pu * rc;
#pragma unroll
                    for (int e = 0; e < 4; ++e) o[n * 4 + e] = ov[e]; }
                u32x4 w; w.x = cvt_pk_bf16(o[0], o[1]); w.y = cvt_pk_bf16(o[2], o[3]); w.z = cvt_pk_bf16(o[4], o[5]); w.w = cvt_pk_bf16(o[6], o[7]);
                *(u32x4*)(act + (size_t)r * DFF + col0) = w; }
    }
};
struct EpiRes {
    static constexpr bool PERM = true, AFTER_DRAIN = false;
    const float* res32; bf16_t* XB; float* ss;
    __device__ __forceinline__ void operator()(const f32x4 (&acc)[2][2][4][2], const pg8::Unit& u, int wr, int wc, int fr, int fq) const {
        const int row0 = u.pm * 256 + wr * 64 + fr, col0 = u.pn * 256 + wc * 32 + 8 * fq;
        if (res32) {
#pragma unroll
            for (int ai = 0; ai < 2; ++ai) {
                f32x4 rv[4][2][2];
#pragma unroll
                for (int m = 0; m < 4; ++m)
#pragma unroll
                    for (int bj = 0; bj < 2; ++bj)
#pragma unroll
                        for (int n = 0; n < 2; ++n) rv[m][bj][n] = *(const f32x4*)(res32 + (size_t)(row0 + ai * 128 + m * 16) * DM + col0 + bj * 128 + n * 4);
                asm volatile("" ::: "memory");
#pragma unroll
                for (int m = 0; m < 4; ++m) { const int r = row0 + ai * 128 + m * 16; float sq = 0.f;
#pragma unroll
                    for (int bj = 0; bj < 2; ++bj) { const f32x4 v0 = rv[m][bj][0] + acc[ai][bj][m][0], v1 = rv[m][bj][1] + acc[ai][bj][m][1];
                        sq += ((v0[0] * v0[0] + v0[1] * v0[1]) + (v0[2] * v0[2] + v0[3] * v0[3])) + ((v1[0] * v1[0] + v1[1] * v1[1]) + (v1[2] * v1[2] + v1[3] * v1[3]));
                        u32x4 w; w.x = cvt_pk_bf16(v0[0], v0[1]); w.y = cvt_pk_bf16(v0[2], v0[3]); w.z = cvt_pk_bf16(v1[0], v1[1]); w.w = cvt_pk_bf16(v1[2], v1[3]);
                        *(u32x4*)(XB + (size_t)r * DM + col0 + bj * 128) = w; }
                    sq += __shfl_xor(sq, 16); sq += __shfl_xor(sq, 32);
                    if (fq == 0) ss[(size_t)r * 16 + u.pn * 4 + wc] = sq; }
            }
        } else {
            u32x4 rb[2][4][2];
#pragma unroll
            for (int ai = 0; ai < 2; ++ai)
#pragma unroll
                for (int m = 0; m < 4; ++m)
#pragma unroll
                    for (int bj = 0; bj < 2; ++bj) rb[ai][m][bj] = *(const u32x4*)(XB + (size_t)(row0 + ai * 128 + m * 16) * DM + col0 + bj * 128);
            asm volatile("" ::: "memory");
#pragma unroll
            for (int ai = 0; ai < 2; ++ai)
#pragma unroll
                for (int m = 0; m < 4; ++m) { const int r = row0 + ai * 128 + m * 16; float sq = 0.f;
#pragma unroll
                    for (int bj = 0; bj < 2; ++bj) { const u32x4 q = rb[ai][m][bj];
                        f32x4 v0, v1; v0[0] = __uint_as_float(q.x << 16); v0[1] = __uint_as_float(q.x & 0xffff0000u); v0[2] = __uint_as_float(q.y << 16); v0[3] = __uint_as_float(q.y & 0xffff0000u);
                        v1[0] = __uint_as_float(q.z << 16); v1[1] = __uint_as_float(q.z & 0xffff0000u); v1[2] = __uint_as_float(q.w << 16); v1[3] = __uint_as_float(q.w & 0xffff0000u);
                        v0 = v0 + acc[ai][bj][m][0]; v1 = v1 + acc[ai][bj][m][1];
                        sq += ((v0[0] * v0[0] + v0[1] * v0[1]) + (v0[2] * v0[2] + v0[3] * v0[3])) + ((v1[0] * v1[0] + v1[1] * v1[1]) + (v1[2] * v1[2] + v1[3] * v1[3]));
                        u32x4 w; w.x = cvt_pk_bf16(v0[0], v0[1]); w.y = cvt_pk_bf16(v0[2], v0[3]); w.z = cvt_pk_bf16(v1[0], v1[1]); w.w = cvt_pk_bf16(v1[2], v1[3]);
                        *(u32x4*)(XB + (size_t)r * DM + col0 + bj * 128) = w; }
                    sq += __shfl_xor(sq, 16); sq += __shfl_xor(sq, 32);
                    if (fq == 0) ss[(size_t)r * 16 + u.pn * 4 + wc] = sq; }
        }
    }
};
struct EpiIn {
    static constexpr bool PERM = true, AFTER_DRAIN = false;
    bf16_t* IN; float* small; const float* ss; mutable int cpm;
    __device__ __forceinline__ void operator()(const f32x4 (&acc)[2][2][4][2], const pg8::Unit& u, int wr, int wc, int fr, int fq) const {
        const int row0 = u.pm * 256 + wr * 64 + fr, col0 = u.pn * 256 + wc * 32 + 8 * fq;
        float rsv[8]; rows_rstd_cached(ss, u.pm, wr, wc, fr, cpm, rsv);
        if (u.pn < 22) {
#pragma unroll
            for (int ai = 0; ai < 2; ++ai)
#pragma unroll
                for (int m = 0; m < 4; ++m) { const int r = row0 + ai * 128 + m * 16; const float rs = rsv[ai * 4 + m];
#pragma unroll
                    for (int bj = 0; bj < 2; ++bj) { const f32x4 v0 = acc[ai][bj][m][0] * rs, v1 = acc[ai][bj][m][1] * rs;
                        u32x4 w; w.x = cvt_pk_bf16(v0[0], v0[1]); w.y = cvt_pk_bf16(v0[2], v0[3]); w.z = cvt_pk_bf16(v1[0], v1[1]); w.w = cvt_pk_bf16(v1[2], v1[3]);
                        *(u32x4*)(IN + (size_t)r * IN_LD + col0 + bj * 128) = w; } }
        } else if (wc == 0) {
#pragma unroll
            for (int ai = 0; ai < 2; ++ai)
#pragma unroll
                for (int m = 0; m < 4; ++m) { const int r = row0 + ai * 128 + m * 16; const float rs = rsv[ai * 4 + m];
                    *(f32x4*)(small + (size_t)r * 32 + 8 * fq) = acc[ai][0][m][0] * rs; *(f32x4*)(small + (size_t)r * 32 + 8 * fq + 4) = acc[ai][0][m][1] * rs; }
        }
    }
};
struct EpiD1 {
    static constexpr bool PERM = false, AFTER_DRAIN = false;
    float* raw; const float* ss; mutable int cpm;
    __device__ __forceinline__ void operator()(const f32x4 (&acc)[2][2][4][2], const pg8::Unit& u, int wr, int wc, int fr, int fq) const {
        const int row0 = u.pm * 256 + wr * 64 + fr, col0 = u.pn * 256 + wc * 32 + 4 * fq;
        float rsv[8]; rows_rstd_cached(ss, u.pm, wr, wc, fr, cpm, rsv);
#pragma unroll
        for (int ai = 0; ai < 2; ++ai)
#pragma unroll
            for (int m = 0; m < 4; ++m) { const int r = row0 + ai * 128 + m * 16; const float rs = rsv[ai * 4 + m];
#pragma unroll
                for (int bj = 0; bj < 2; ++bj)
#pragma unroll
                    for (int n = 0; n < 2; ++n) *(f32x4*)(raw + (size_t)r * 512 + col0 + bj * 128 + n * 16) = acc[ai][bj][m][n] * rs; }
    }
};
struct EpiD1F {
    static constexpr bool PERM = false, AFTER_DRAIN = true;
    const float* ss; bf16_t* QL; bf16_t* KV; bf16_t* KI; float* WI; const float* qg; const float* kg; const float* lg; const float* lb; mutable int cpm;
    __device__ __forceinline__ void fused(f32x4 (&acc)[2][2][4][2], const pg8::Unit& u, int wr, int wc, int fr, int fq, LAS unsigned char* lds, int wid, int lane) const {
        (void)wid; (void)lane;
        float rsv[8]; rows_rstd_cached(ss, u.pm, wr, wc, fr, cpm, rsv);
#pragma unroll
        for (int ai = 0; ai < 2; ++ai)
#pragma unroll
            for (int m = 0; m < 4; ++m)
#pragma unroll
                for (int bj = 0; bj < 2; ++bj)
#pragma unroll
                    for (int n = 0; n < 2; ++n) acc[ai][bj][m][n] = acc[ai][bj][m][n] * rsv[ai * 4 + m];
        LAS f32x4* P = (LAS f32x4*)lds;
        const int rl0 = wr * 64 + fr;
        if (u.pn == 0) {
#pragma unroll
            for (int ai = 0; ai < 2; ++ai)
#pragma unroll
                for (int m = 0; m < 4; ++m) { float sq = 0.f;
#pragma unroll
                    for (int bj = 0; bj < 2; ++bj)
#pragma unroll
                        for (int n = 0; n < 2; ++n) { const f32x4 v = acc[ai][bj][m][n]; sq += (v[0] * v[0] + v[1] * v[1]) + (v[2] * v[2] + v[3] * v[3]); }
                    sq += __shfl_xor(sq, 16); sq += __shfl_xor(sq, 32);
                    if (fq == 0) P[(ai * 128 + rl0 + m * 16) * 4 + wc] = (f32x4){sq, 0.f, 0.f, 0.f}; }
            __syncthreads();
#pragma unroll
            for (int ai = 0; ai < 2; ++ai)
#pragma unroll
                for (int m = 0; m < 4; ++m) { const int rl = ai * 128 + rl0 + m * 16; const size_t row = (size_t)u.pm * 256 + rl;
                    const float tot = (P[rl * 4 + 0][0] + P[rl * 4 + 1][0]) + (P[rl * 4 + 2][0] + P[rl * 4 + 3][0]); const float rq = rsqrtf(tot * (1.0f / 256.0f) + 1e-6f);
#pragma unroll
                    for (int bj = 0; bj < 2; ++bj)
#pragma unroll
                        for (int n = 0; n < 2; ++n) { const int c = bj * 128 + wc * 32 + n * 16 + 4 * fq; const f32x4 g = *(const f32x4*)(qg + c); const f32x4 v = acc[ai][bj][m][n] * rq * g;
                            u32x2 w; w.x = cvt_pk_bf16(v[0], v[1]); w.y = cvt_pk_bf16(v[2], v[3]); *(u32x2*)(QL + row * 256 + c) = w; } }
        } else {
#pragma unroll
            for (int ai = 0; ai < 2; ++ai)
#pragma unroll
                for (int m = 0; m < 4; ++m) { float skv = 0.f, s1 = 0.f, s2 = 0.f;
#pragma unroll
                    for (int n = 0; n < 2; ++n) { const f32x4 v = acc[ai][0][m][n]; skv += (v[0] * v[0] + v[1] * v[1]) + (v[2] * v[2] + v[3] * v[3]);
                        const f32x4 k = acc[ai][1][m][n]; s1 += (k[0] + k[1]) + (k[2] + k[3]); s2 += (k[0] * k[0] + k[1] * k[1]) + (k[2] * k[2] + k[3] * k[3]); }
                    if (wc >= 2) { s1 = 0.f; s2 = 0.f; }
                    skv += __shfl_xor(skv, 16); skv += __shfl_xor(skv, 32); s1 += __shfl_xor(s1, 16); s1 += __shfl_xor(s1, 32); s2 += __shfl_xor(s2, 16); s2 += __shfl_xor(s2, 32);
                    if (fq == 0) P[(ai * 128 + rl0 + m * 16) * 4 + wc] = (f32x4){skv, s1, s2, 0.f}; }
            __syncthreads();
#pragma unroll
            for (int ai = 0; ai < 2; ++ai)
#pragma unroll
                for (int m = 0; m < 4; ++m) { const int rl = ai * 128 + rl0 + m * 16; const size_t row = (size_t)u.pm * 256 + rl;
                    const f32x4 p0 = P[rl * 4 + 0], p1 = P[rl * 4 + 1], p2 = P[rl * 4 + 2], p3 = P[rl * 4 + 3];
                    const float rkv = rsqrtf(((p0[0] + p1[0]) + (p2[0] + p3[0])) * (1.0f / 128.0f) + 1e-6f);
                    const float mu = (p0[1] + p1[1]) * (1.0f / 64.0f); const float var = fmaxf((p0[2] + p1[2]) * (1.0f / 64.0f) - mu * mu, 0.f); const float rki = rsqrtf(var + 1e-6f);
#pragma unroll
                    for (int n = 0; n < 2; ++n) { const int c = wc * 32 + n * 16 + 4 * fq;
                        { const f32x4 g = *(const f32x4*)(kg + c); const f32x4 v = acc[ai][0][m][n] * rkv * g; u32x2 w; w.x = cvt_pk_bf16(v[0], v[1]); w.y = cvt_pk_bf16(v[2], v[3]); *(u32x2*)(KV + row * 128 + c) = w; }
                        if (wc < 2) { const f32x4 g = *(const f32x4*)(lg + c), bb = *(const f32x4*)(lb + c); const f32x4 v = (acc[ai][1][m][n] - mu) * rki * g + bb;
                            u32x2 w; w.x = cvt_pk_bf16(v[0], v[1]); w.y = cvt_pk_bf16(v[2], v[3]); *(u32x2*)(KI + row * 64 + c) = w; }
                        else if (wc == 2 && n == 0) *(f32x4*)(WI + row * 16 + 4 * fq) = acc[ai][1][m][0] * 0.03125f; } }
        }
        __syncthreads();
    }
};
struct EpiD3 {
    static constexpr bool PERM = true, AFTER_DRAIN = false;
    bf16_t* Q; bf16_t* QI;
    __device__ __forceinline__ void operator()(const f32x4 (&acc)[2][2][4][2], const pg8::Unit& u, int wr, int wc, int fr, int fq) const {
        const int row0 = u.pm * 256 + wr * 64 + fr; const bool isq = u.pn < 8;
        bf16_t* base = isq ? Q : QI; const int ld = isq ? 2048 : 1024; const int col0 = (isq ? u.pn : u.pn - 8) * 256 + wc * 32 + 8 * fq;
#pragma unroll
        for (int ai = 0; ai < 2; ++ai)
#pragma unroll
            for (int m = 0; m < 4; ++m) { const int r = row0 + ai * 128 + m * 16;
#pragma unroll
                for (int bj = 0; bj < 2; ++bj) { const f32x4 v0 = acc[ai][bj][m][0], v1 = acc[ai][bj][m][1];
                    u32x4 w; w.x = cvt_pk_bf16(v0[0], v0[1]); w.y = cvt_pk_bf16(v0[2], v0[3]); w.z = cvt_pk_bf16(v1[0], v1[1]); w.w = cvt_pk_bf16(v1[2], v1[3]);
                    *(u32x4*)(base + (size_t)r * ld + col0 + bj * 128) = w; } }
    }
};
template <class Epi> __device__ __forceinline__ void run_gemm(LAS unsigned char* lds, const bf16_t* A, int lda, const bf16_t* Bt, int M, int N, int K, const Epi& E, int wgm = 8) {
    pg8::Gemm g; g.A = A; g.Bt = Bt; g.M = M; g.N = N; g.K = K; g.lda = lda;
    pg8::StaticOrder S; S.init(M, N, (int)gridDim.x, (int)blockIdx.x, wgm);
    pg8::gemm_phase<Epi, pg8::StaticOrder>(lds, g, S, E);
}

struct PrepJob { const float* src; int src_ld, col0, ncols, K; bf16_t* dst; int grp, grp_stride, grp_off; const float* gain; float scale; };
__device__ __forceinline__ PrepJob mkjob(const float* src, int src_ld, int col0, int ncols, int K, bf16_t* dst, int grp, int gs, int go, const float* gain, float scale) {
    PrepJob j; j.src = src; j.src_ld = src_ld; j.col0 = col0; j.ncols = ncols; j.K = K; j.dst = dst; j.grp = grp; j.grp_stride = gs; j.grp_off = go; j.gain = gain; j.scale = scale; return j; }
__device__ __forceinline__ PrepJob get_job(int j) {
    const int BIG = 1 << 30; unsigned char* ws = PWS;
    if (j < 12) { const int lf = j / 3, k = j % 3;
        if (k == 0) return mkjob(PIN(2) + (size_t)lf * 1024 * 2816, 2816, 0, 2816, 1024, (bf16_t*)(ws + W_GU + lf * W_GU_SZ), 128, 256, 0, PIN(1) + lf * 1024, 1.0f);
        if (k == 1) return mkjob(PIN(3) + (size_t)lf * 1024 * 2816, 2816, 0, 2816, 1024, (bf16_t*)(ws + W_GU + lf * W_GU_SZ), 128, 256, 128, PIN(1) + lf * 1024, 1.0f);
        return mkjob(PIN(4) + (size_t)lf * 2816 * 1024, 1024, 0, 1024, 2816, (bf16_t*)(ws + W_D + lf * W_D_SZ), BIG, 0, 0, nullptr, 0.5f); }
    j -= 12;
    if (j < 8) { bf16_t* d = (bf16_t*)(ws + W_IN); const float* s = PIN(6); const float* gn = PIN(5);
        switch (j) {
            case 0: return mkjob(s, 5664, 0, 512, 1024, d, BIG, 0, 0, gn, 0.08838834764831845f);
            case 1: return mkjob(s, 5664, 512, 512, 1024, d, BIG, 0, 512, gn, 1.0f);
            case 2: return mkjob(s, 5664, 1024, 1024, 1024, d, BIG, 0, 1024, gn, 1.0f);
            case 3: return mkjob(s, 5664, 2048, 1024, 1024, d, BIG, 0, 2048, gn, 1.0f);
            case 4: return mkjob(s, 5664, 3072, 16, 1024, d, BIG, 0, 5632, gn, 1.0f);
            case 5: return mkjob(s, 5664, 3088, 1024, 1024, d, BIG, 0, 3072, gn, 1.0f);
            case 6: return mkjob(s, 5664, 4112, 1536, 1024, d, BIG, 0, 4096, gn, 1.0f);
            default: return mkjob(s, 5664, 5648, 16, 1024, d, BIG, 0, 5648, gn, 1.0f);
        } }
    j -= 8;
    if (j == 0) return mkjob(PIN(16), 1024, 0, 1024, 2048, (bf16_t*)(ws + W_OUT), BIG, 0, 0, nullptr, 1.0f);
    j -= 1;
    if (j < 4) { bf16_t* d = (bf16_t*)(ws + W_D1); const float* gn = PIN(5) + 1024;
        switch (j) {
            case 0: return mkjob(PIN(17), 256, 0, 256, 1024, d, BIG, 0, 0, gn, 1.0f);
            case 1: return mkjob(PIN(20), 128, 0, 128, 1024, d, BIG, 0, 256, gn, 1.0f);
            case 2: return mkjob(PIN(25), 64, 0, 64, 1024, d, BIG, 0, 384, gn, 1.0f);
            default: return mkjob(PIN(28), 16, 0, 16, 1024, d, BIG, 0, 448, gn, 1.0f);
        } }
    j -= 4;
    if (j == 0) return mkjob(PIN(19), 2048, 0, 2048, 256, (bf16_t*)(ws + W_D3), BIG, 0, 0, nullptr, 0.08838834764831845f);
    return mkjob(PIN(24), 1024, 0, 1024, 256, (bf16_t*)(ws + W_D3), BIG, 0, 2048, nullptr, 1.0f);
}
constexpr int N_PREP_JOBS = 27;

__device__ __forceinline__ void phase_prologue(LAS unsigned char* lds) {
    const int tid = threadIdx.x, wid = tid >> 6, lane = tid & 63;
    { const float* x = PIN(0); bf16_t* XB = (bf16_t*)(PWS + WS_XB); float* ss = (float*)(PWS + WS_SS);
      for (int row = blockIdx.x * 8 + wid; row < T_TOK; row += gridDim.x * 8) {
          float sq = 0.f;
#pragma unroll
          for (int i = 0; i < 4; ++i) { const size_t o = (size_t)row * DM + i * 256 + lane * 4; const f32x4 v = *(const f32x4*)(x + o);
              sq += (v[0] * v[0] + v[1] * v[1]) + (v[2] * v[2] + v[3] * v[3]); u32x2 w; w.x = cvt_pk_bf16(v[0], v[1]); w.y = cvt_pk_bf16(v[2], v[3]); *(u32x2*)(XB + o) = w; }
          sq = wave_sum(sq);
          if (lane < 16) ss[(size_t)row * 16 + lane] = lane == 0 ? sq : 0.f; } }
    LAS bf16_t* Tl = (LAS bf16_t*)lds;
    for (int j = 0; j < N_PREP_JOBS; ++j) { const PrepJob J = get_job(j); const int nct = (J.ncols + 63) / 64, nt = (J.K / 64) * nct;
        for (int tile = blockIdx.x; tile < nt; tile += gridDim.x) { const int k0 = (tile / nct) * 64, n0 = (tile % nct) * 64;
#pragma unroll
            for (int i = 0; i < 2; ++i) { const int kl = (tid >> 4) + 32 * i, nl = (tid & 15) * 4;
                if (n0 + nl < J.ncols) { const f32x4 v = *(const f32x4*)(J.src + (size_t)(k0 + kl) * J.src_ld + J.col0 + n0 + nl); const float s = J.scale * (J.gain ? J.gain[k0 + kl] : 1.0f);
                    Tl[(nl + 0) * 72 + kl] = f2bf(v[0] * s); Tl[(nl + 1) * 72 + kl] = f2bf(v[1] * s); Tl[(nl + 2) * 72 + kl] = f2bf(v[2] * s); Tl[(nl + 3) * 72 + kl] = f2bf(v[3] * s); } }
            __syncthreads();
            { const int n = tid >> 3, k8 = (tid & 7) * 8;
              if (n0 + n < J.ncols) { const int jj = n0 + n, dr = (jj / J.grp) * J.grp_stride + J.grp_off + (jj % J.grp);
                  *(u32x4*)(J.dst + (size_t)dr * J.K + k0 + k8) = *(const LAS u32x4*)(Tl + n * 72 + k8); } }
            __syncthreads(); } }
    { u32x4 z = {0u, 0u, 0u, 0u}; u32x4* a = (u32x4*)(PWS + W_IN + (size_t)5664 * 1024 * 2); const int na = 224 * 1024 * 2 / 16;
      for (int i = blockIdx.x * 512 + tid; i < na; i += gridDim.x * 512) a[i] = z;
      u32x4* b = (u32x4*)(PWS + W_D1 + (size_t)464 * 1024 * 2); const int nb = 48 * 1024 * 2 / 16;
      for (int i = blockIdx.x * 512 + tid; i < nb; i += gridDim.x * 512) b[i] = z; }
    { const float* wuv = PIN(22); const float* wo = PIN(23); bf16_t* WC = (bf16_t*)(PWS + W_C);
      for (int it = blockIdx.x * 512 + tid; it < 1024 * 256; it += gridDim.x * 512) { const int d = it & 1023, cb = it >> 10, h = cb >> 4, c0 = (cb & 15) * 8;
          float a[8] = {0.f, 0.f, 0.f, 0.f, 0.f, 0.f, 0.f, 0.f};
          for (int e = 0; e < 64; ++e) { const float w = wo[(size_t)(h * 64 + e) * 1024 + d];
#pragma unroll
              for (int i = 0; i < 8; ++i) a[i] += wuv[((size_t)h * 128 + c0 + i) * 64 + e] * w; }
          u32x4 o; o.x = cvt_pk_bf16(a[0], a[1]); o.y = cvt_pk_bf16(a[2], a[3]); o.z = cvt_pk_bf16(a[4], a[5]); o.w = cvt_pk_bf16(a[6], a[7]);
          *(u32x4*)(WC + (size_t)d * 2048 + h * 128 + c0) = o; } }
}

#define MFMA16(a, b, c) __builtin_amdgcn_mfma_f32_16x16x32_bf16((a), (b), (c), 0, 0, 0)
__device__ __forceinline__ bf16x8 frag_row(LAS unsigned char* base, int row0, int stride, int k0, int lane) {
    return *(const LAS bf16x8*)(base + (row0 + (lane & 15)) * stride + (k0 + 8 * (lane >> 4)) * 2); }
#define LDS_FENCE() asm volatile("s_waitcnt lgkmcnt(0)" ::: "memory")

#define DPP_F(v, ctrl) __builtin_bit_cast(float, __builtin_amdgcn_update_dpp(0, __builtin_bit_cast(int, (v)), (ctrl), 0xF, 0xF, true))
__device__ __forceinline__ float row16_max(float v) { v = fmaxf(v, DPP_F(v, 0xB1)); v = fmaxf(v, DPP_F(v, 0x4E)); v = fmaxf(v, DPP_F(v, 0x141)); v = fmaxf(v, DPP_F(v, 0x140)); return v; }
__device__ __forceinline__ float row16_sum(float v) { v += DPP_F(v, 0xB1); v += DPP_F(v, 0x4E); v += DPP_F(v, 0x141); v += DPP_F(v, 0x140); return v; }
__device__ __forceinline__ float swap16_add(float a, float b) { const auto r = __builtin_amdgcn_permlane16_swap(__float_as_uint(a), __float_as_uint(b), false, false); return __uint_as_float(r[0]) + __uint_as_float(r[1]); }
__device__ __forceinline__ float swap32_add(float a, float b) { const auto r = __builtin_amdgcn_permlane32_swap(__float_as_uint(a), __float_as_uint(b), false, false); return __uint_as_float(r[0]) + __uint_as_float(r[1]); }
__device__ __forceinline__ float rows4_total(float a, float b, float c, float d) { return swap32_add(swap16_add(a, b), swap16_add(c, d)); }
__device__ __forceinline__ bf16x8 tr_pack(u32x2 lo, u32x2 hi) { u32x4 w; w.x = lo.x; w.y = lo.y; w.z = hi.x; w.w = hi.y; return __builtin_bit_cast(bf16x8, w); }
__device__ __forceinline__ void tr_batch_pv(bf16x8 (&f)[8], unsigned b0) {
    u32x2 r[16];
    asm volatile("ds_read_b64_tr_b16 %0, %16 offset:0\n\t"
        "ds_read_b64_tr_b16 %1, %16 offset:1088\n\t"
        "ds_read_b64_tr_b16 %2, %16 offset:32\n\t"
        "ds_read_b64_tr_b16 %3, %16 offset:1120\n\t"
        "ds_read_b64_tr_b16 %4, %16 offset:64\n\t"
        "ds_read_b64_tr_b16 %5, %16 offset:1152\n\t"
        "ds_read_b64_tr_b16 %6, %16 offset:96\n\t"
        "ds_read_b64_tr_b16 %7, %16 offset:1184\n\t"
        "ds_read_b64_tr_b16 %8, %16 offset:128\n\t"
        "ds_read_b64_tr_b16 %9, %16 offset:1216\n\t"
        "ds_read_b64_tr_b16 %10, %16 offset:160\n\t"
        "ds_read_b64_tr_b16 %11, %16 offset:1248\n\t"
        "ds_read_b64_tr_b16 %12, %16 offset:192\n\t"
        "ds_read_b64_tr_b16 %13, %16 offset:1280\n\t"
        "ds_read_b64_tr_b16 %14, %16 offset:224\n\t"
        "ds_read_b64_tr_b16 %15, %16 offset:1312\n\t"
        "s_waitcnt lgkmcnt(0)"
        : "=&v"(r[0]), "=&v"(r[1]), "=&v"(r[2]), "=&v"(r[3]), "=&v"(r[4]), "=&v"(r[5]), "=&v"(r[6]), "=&v"(r[7]), "=&v"(r[8]), "=&v"(r[9]), "=&v"(r[10]), "=&v"(r[11]), "=&v"(r[12]), "=&v"(r[13]), "=&v"(r[14]), "=&v"(r[15]) : "v"(b0) : "memory");
#pragma unroll
    for (int i = 0; i < 8; ++i) f[i] = tr_pack(r[2 * i], r[2 * i + 1]);
}
__device__ __forceinline__ void tr_batch_s2(bf16x8 (&f)[6], unsigned b0, unsigned b1) {
    u32x2 r[12];
    asm volatile("ds_read_b64_tr_b16 %0, %12 offset:0\n\t"
        "ds_read_b64_tr_b16 %1, %12 offset:576\n\t"
        "ds_read_b64_tr_b16 %2, %12 offset:4608\n\t"
        "ds_read_b64_tr_b16 %3, %12 offset:5184\n\t"
        "ds_read_b64_tr_b16 %4, %13 offset:0\n\t"
        "ds_read_b64_tr_b16 %5, %13 offset:576\n\t"
        "ds_read_b64_tr_b16 %6, %13 offset:4608\n\t"
        "ds_read_b64_tr_b16 %7, %13 offset:5184\n\t"
        "ds_read_b64_tr_b16 %8, %13 offset:9216\n\t"
        "ds_read_b64_tr_b16 %9, %13 offset:9792\n\t"
        "ds_read_b64_tr_b16 %10, %13 offset:13824\n\t"
        "ds_read_b64_tr_b16 %11, %13 offset:14400\n\t"
        "s_waitcnt lgkmcnt(0)"
        : "=&v"(r[0]), "=&v"(r[1]), "=&v"(r[2]), "=&v"(r[3]), "=&v"(r[4]), "=&v"(r[5]), "=&v"(r[6]), "=&v"(r[7]), "=&v"(r[8]), "=&v"(r[9]), "=&v"(r[10]), "=&v"(r[11]) : "v"(b0), "v"(b1) : "memory");
#pragma unroll
    for (int i = 0; i < 6; ++i) f[i] = tr_pack(r[2 * i], r[2 * i + 1]);
}
__device__ __forceinline__ void tr_batch_s3(bf16x8 (&f)[10], unsigned b0, unsigned b1) {
    u32x2 r[20];
    asm volatile("ds_read_b64_tr_b16 %0, %20 offset:0\n\t"
        "ds_read_b64_tr_b16 %1, %20 offset:1088\n\t"
        "ds_read_b64_tr_b16 %2, %20 offset:8704\n\t"
        "ds_read_b64_tr_b16 %3, %20 offset:9792\n\t"
        "ds_read_b64_tr_b16 %4, %21 offset:0\n\t"
        "ds_read_b64_tr_b16 %5, %21 offset:576\n\t"
        "ds_read_b64_tr_b16 %6, %21 offset:4608\n\t"
        "ds_read_b64_tr_b16 %7, %21 offset:5184\n\t"
        "ds_read_b64_tr_b16 %8, %21 offset:32\n\t"
        "ds_read_b64_tr_b16 %9, %21 offset:608\n\t"
        "ds_read_b64_tr_b16 %10, %21 offset:4640\n\t"
        "ds_read_b64_tr_b16 %11, %21 offset:5216\n\t"
        "ds_read_b64_tr_b16 %12, %21 offset:64\n\t"
        "ds_read_b64_tr_b16 %13, %21 offset:640\n\t"
        "ds_read_b64_tr_b16 %14, %21 offset:4672\n\t"
        "ds_read_b64_tr_b16 %15, %21 offset:5248\n\t"
        "ds_read_b64_tr_b16 %16, %21 offset:96\n\t"
        "ds_read_b64_tr_b16 %17, %21 offset:672\n\t"
        "ds_read_b64_tr_b16 %18, %21 offset:4704\n\t"
        "ds_read_b64_tr_b16 %19, %21 offset:5280\n\t"
        "s_waitcnt lgkmcnt(0)"
        : "=&v"(r[0]), "=&v"(r[1]), "=&v"(r[2]), "=&v"(r[3]), "=&v"(r[4]), "=&v"(r[5]), "=&v"(r[6]), "=&v"(r[7]), "=&v"(r[8]), "=&v"(r[9]), "=&v"(r[10]), "=&v"(r[11]), "=&v"(r[12]), "=&v"(r[13]), "=&v"(r[14]), "=&v"(r[15]), "=&v"(r[16]), "=&v"(r[17]), "=&v"(r[18]), "=&v"(r[19]) : "v"(b0), "v"(b1) : "memory");
#pragma unroll
    for (int i = 0; i < 10; ++i) f[i] = tr_pack(r[2 * i], r[2 * i + 1]);
}
__device__ __forceinline__ void phase_small_proj() {
    const int tid = threadIdx.x, wid = tid >> 6, lane = tid & 63, r16 = lane & 15, g4 = lane >> 4;
    const bf16_t* XB = (const bf16_t*)(PWS + WS_XB); const bf16_t* W = (const bf16_t*)(PWS + W_IN) + (size_t)5632 * 1024; float* small = (float*)(PWS + WS_SMALL); const float* ss = (const float*)(PWS + WS_SS);
    for (int rb = blockIdx.x; rb < T_TOK / 128; rb += gridDim.x) {
        const int row0 = rb * 128 + wid * 16;
        const bf16_t* ap = XB + (size_t)(row0 + r16) * 1024 + 8 * g4; const bf16_t* bp0 = W + (size_t)r16 * 1024 + 8 * g4; const bf16_t* bp1 = bp0 + 16 * 1024;
        f32x4 a0 = {0.f, 0.f, 0.f, 0.f}, a1 = {0.f, 0.f, 0.f, 0.f};
#pragma unroll 8
        for (int s = 0; s < 32; ++s) { const bf16x8 a = *(const bf16x8*)(ap + 32 * s), b0 = *(const bf16x8*)(bp0 + 32 * s), b1 = *(const bf16x8*)(bp1 + 32 * s);
            a0 = MFMA16(a, b0, a0); a1 = MFMA16(a, b1, a1); }
#pragma unroll
        for (int jj = 0; jj < 4; ++jj) { const int row = row0 + 4 * g4 + jj; const float rs = row_rstd(ss, row);
            small[(size_t)row * 32 + r16] = a0[jj] * rs; small[(size_t)row * 32 + 16 + r16] = a1[jj] * rs; }
    }
}
constexpr int RS128 = 272, RS64 = 144;
__device__ __forceinline__ void prep_gla_unit(int g, LAS unsigned char* lds) {
    const int tid = threadIdx.x; bf16_t* IN = (bf16_t*)(PWS + WS_IN); const float* SM = (const float*)(PWS + WS_SMALL);
    bf16_t* KDB = (bf16_t*)POUT; float* DECB = (float*)((unsigned char*)POUT + 32 * MiB);
    LAS float* glr = (LAS float*)lds; LAS float* segs = glr + 1024;
    const int b = g >> 8, c = (g >> 2) & 63, h = g & 3, t0 = b * SEQ + c * 64, k = tid & 127, seg = tid >> 7;
    float w2[16]; const float* w2p = PIN(7);
#pragma unroll
    for (int r = 0; r < 16; ++r) w2[r] = w2p[r * 512 + h * 128 + k];
    const float bk = PIN(8)[h * 128 + k];
    unsigned qk[16];
#pragma unroll
    for (int jj = 0; jj < 16; ++jj) { const size_t o = (size_t)(t0 + seg * 16 + jj) * IN_LD; qk[jj] = (unsigned)IN[o + C_Q + h * 128 + k] | ((unsigned)IN[o + C_K + h * 128 + k] << 16); }
    if (tid < 256) *(LAS u32x4*)(glr + (tid >> 2) * 16 + (tid & 3) * 4) = *(const u32x4*)(SM + (size_t)(t0 + (tid >> 2)) * 32 + (tid & 3) * 4);
    __syncthreads();
    float cs[16]; float run = 0.f;
#pragma unroll
    for (int jj = 0; jj < 16; ++jj) { const LAS f32x4* gp = (const LAS f32x4*)(glr + (seg * 16 + jj) * 16); float x = bk;
#pragma unroll
        for (int q4 = 0; q4 < 4; ++q4) { const f32x4 gv = gp[q4]; x += gv[0] * w2[q4 * 4 + 0] + gv[1] * w2[q4 * 4 + 1] + gv[2] * w2[q4 * 4 + 2] + gv[3] * w2[q4 * 4 + 3]; }
        const float lg = (fminf(x, 0.f) - __logf(1.0f + __expf(-fabsf(x)))) * 0.0625f; run += lg; cs[jj] = run; }
    segs[seg * 128 + k] = run;
    __syncthreads();
    float off = 0.f, tot = 0.f;
#pragma unroll
    for (int s = 0; s < 4; ++s) { const float v = segs[s * 128 + k]; tot += v; if (s < seg) off += v; }
    const float etot = __expf(tot);
#pragma unroll
    for (int jj = 0; jj < 16; ++jj) { const float bc = off + cs[jj], qv = __uint_as_float(qk[jj] << 16), kv = __uint_as_float(qk[jj] & 0xffff0000u); const size_t o = (size_t)(t0 + seg * 16 + jj) * IN_LD;
        const float e1 = __expf(bc), e2 = __builtin_amdgcn_rcpf(e1);
        IN[o + C_Q + h * 128 + k] = f2bf(qv * e1); IN[o + C_K + h * 128 + k] = f2bf(kv * e2);
        KDB[(size_t)(t0 + seg * 16 + jj) * 512 + h * 128 + k] = f2bf(kv * (etot * e2)); }
    if (seg == 0) DECB[(size_t)(b * 64 + c) * 512 + h * 128 + k] = etot;
    __syncthreads();
}
__device__ __forceinline__ void prep_conv_unit(int u, LAS unsigned char* lds) {
    const int tid = threadIdx.x; bf16_t* IN = (bf16_t*)(PWS + WS_IN);
    const int b = u / 24, strip = u % 24, r = tid >> 3, c8 = (tid & 7) * 8, col = C_X + strip * 64 + c8, ch = strip * 64 + c8;
    LAS unsigned char* rawt = lds + 16384;
    float wk[4][8], bb[8];
    { const float* cwp = PIN(10); const float* cbp = PIN(11);
#pragma unroll
      for (int kk = 0; kk < 4; ++kk)
#pragma unroll
          for (int e = 0; e < 8; ++e) wk[kk][e] = cwp[kk * 1536 + ch + e];
#pragma unroll
      for (int e = 0; e < 8; ++e) bb[e] = cbp[ch + e]; }
    if (tid < 24) *(LAS u32x4*)(rawt + (189 + (tid >> 3)) * RS64 + (tid & 7) * 16) = (u32x4){0u, 0u, 0u, 0u};
    u32x4 nxt = *(const u32x4*)(IN + (size_t)(b * SEQ + r) * IN_LD + col);
    int slot = 0;
    for (int c = 0; c < 64; ++c) {
        int t0 = b * SEQ + c * 64; asm volatile("" : "+s"(t0));
        *(LAS u32x4*)(rawt + (slot * 64 + r) * RS64 + c8 * 2) = nxt;
        if (c + 1 < 64) nxt = *(const u32x4*)(IN + (size_t)(t0 + 64 + r) * IN_LD + col);
        __syncthreads();
        float a8[8];
#pragma unroll
        for (int e = 0; e < 8; ++e) a8[e] = bb[e];
#pragma unroll
        for (int kk = 0; kk < 4; ++kk) { int row = slot * 64 + r - 3 + kk; row = row < 0 ? row + 192 : row; const u32x4 rv = *(const LAS u32x4*)(rawt + row * RS64 + c8 * 2);
#pragma unroll
            for (int e = 0; e < 4; ++e) { a8[2 * e] += wk[kk][2 * e] * __uint_as_float(rv[e] << 16); a8[2 * e + 1] += wk[kk][2 * e + 1] * __uint_as_float(rv[e] & 0xffff0000u); } }
#pragma unroll
        for (int e = 0; e < 8; ++e) a8[e] = silu_f(a8[e]);
        u32x4 o; o.x = cvt_pk_bf16(a8[0], a8[1]); o.y = cvt_pk_bf16(a8[2], a8[3]); o.z = cvt_pk_bf16(a8[4], a8[5]); o.w = cvt_pk_bf16(a8[6], a8[7]);
        *(u32x4*)(IN + (size_t)(t0 + r) * IN_LD + col) = o;
        slot = slot == 2 ? 0 : slot + 1;
    }
    __syncthreads();
}
__device__ __forceinline__ void phase_prep(LAS unsigned char* lds) {
    const int blk = blockIdx.x;
    if (gridDim.x == 256) {
        if (blk < 192) { prep_conv_unit(blk, lds); for (int i = 0; i < 5; ++i) prep_gla_unit(1088 + blk * 5 + i, lds); }
        else { for (int i = 0; i < 17; ++i) prep_gla_unit((blk - 192) * 17 + i, lds); }
    } else {
        for (int u = blk; u < 192; u += gridDim.x) prep_conv_unit(u, lds);
        for (int g = blk; g < 2048; g += gridDim.x) prep_gla_unit(g, lds);
    }
}

constexpr int SC_QT = 0, SC_KT = 17408, SC_KD = 34816, SC_VV = 52224, SC_AT = 61440, SC_SB = 70656, SC_XS = 89088, SC_MISC = 98304, SC_ZS = 114688;
__device__ __forceinline__ void scan_item(int item, LAS unsigned char* lds, const bool dry, const bool flags8) {
    const int tid0 = threadIdx.x, wid = __builtin_amdgcn_readfirstlane(tid0 >> 6);
    int tid = tid0, lane = tid0 & 63;
    bf16_t* IN = (bf16_t*)(PWS + WS_IN); const float* SM = (const float*)(PWS + WS_SMALL);
    const bool ssd = item >= 128;
    LAS float* misc = (LAS float*)(lds + SC_MISC);
    LAS float* dec = misc + 1536;
    LAS float* dtv = misc + 1792 + wid * 128;
    LAS float* acum = dtv + 64;
    int b, h = 0, vq = 0, hd = 0, grp = 0;
    if (!ssd) { b = item >> 4; h = (item >> 2) & 3; vq = item & 3; } else { const int id = item - 128; b = id >> 4; hd = id & 15; grp = hd >> 3; }
    const int colV = C_V + h * 256 + vq * 64, colZ = C_Z + hd * 64;
    float a_neg = 0.f, dtb = 0.f, Dh = 0.f;
    if (ssd) { a_neg = -__expf(PIN(13)[hd]); dtb = PIN(12)[hd]; Dh = PIN(14)[hd]; }
    const bf16_t* KDB = (const bf16_t*)POUT; const float* DECB = (const float*)((const unsigned char*)POUT + 32 * MiB);
    f32x4 Sacc[4];
#pragma unroll
    for (int i = 0; i < 4; ++i) Sacc[i] = (f32x4){0.f, 0.f, 0.f, 0.f};
    for (int i = tid; i < 128 * RS64 / 4; i += 512) ((LAS unsigned*)(lds + SC_SB))[i] = 0u;
    u32x4 pf[6]; u32x4 vv = {0u, 0u, 0u, 0u}; f32x4 dpf = {0.f, 0.f, 0.f, 0.f};
#pragma unroll
    for (int i = 0; i < 6; ++i) pf[i] = (u32x4){0u, 0u, 0u, 0u};
#define SCAN_PREFETCH(cc) do { int t0p = b * SEQ + (cc) * 64; asm volatile("" : "+s"(t0p)); \
        if (!ssd) { \
            _Pragma("unroll") for (int i = 0; i < 2; ++i) { const int pc = tid + 512 * i, row = pc >> 4, c16 = pc & 15; const size_t o = (size_t)(t0p + row) * IN_LD + h * 128 + c16 * 8; \
                pf[i] = *(const u32x4*)(IN + o + C_Q); pf[2 + i] = *(const u32x4*)(IN + o + C_K); pf[4 + i] = *(const u32x4*)(KDB + (size_t)(t0p + row) * 512 + h * 128 + c16 * 8); } \
            vv = *(const u32x4*)(IN + (size_t)(t0p + (tid >> 3)) * IN_LD + colV + (tid & 7) * 8); \
            if (tid < 32) dpf = *(const f32x4*)(DECB + (size_t)(b * 64 + (cc)) * 512 + h * 128 + tid * 4); \
        } else { \
            pf[0] = *(const u32x4*)(IN + (size_t)(t0p + (tid >> 3)) * IN_LD + C_X + hd * 64 + (tid & 7) * 8); \
            _Pragma("unroll") for (int i = 0; i < 2; ++i) { const int pc = tid + 512 * i, row = pc >> 4, c16 = pc & 15; const size_t o = (size_t)(t0p + row) * IN_LD + grp * 128 + c16 * 8; \
                pf[1 + i] = *(const u32x4*)(IN + o + C_B); pf[3 + i] = *(const u32x4*)(IN + o + C_C); } \
            dpf[0] = SM[(size_t)(t0p + lane) * 32 + 16 + hd]; \
            vv = *(const u32x4*)(IN + (size_t)(t0p + (tid >> 3)) * IN_LD + colZ + (tid & 7) * 8); \
        } } while (0)
    SCAN_PREFETCH(0);
    __syncthreads();

    for (int c = 0; c < 64; ++c) {
        int t0 = b * SEQ + c * 64; asm volatile("" : "+s"(t0));
        tid = tid0; asm volatile("" : "+v"(tid)); lane = tid & 63; const int r16 = lane & 15, g4 = lane >> 4;
        if (!ssd) {
#pragma unroll
            for (int i = 0; i < 2; ++i) { const int pc = tid + 512 * i, row = pc >> 4, c16 = pc & 15;
                *(LAS u32x4*)(lds + SC_QT + row * RS128 + c16 * 16) = pf[i]; *(LAS u32x4*)(lds + SC_KT + row * RS128 + c16 * 16) = pf[2 + i]; *(LAS u32x4*)(lds + SC_KD + row * RS128 + c16 * 16) = pf[4 + i]; }
            *(LAS u32x4*)(lds + SC_VV + (tid >> 3) * RS64 + (tid & 7) * 16) = vv;
            if (tid < 32) *(LAS f32x4*)(dec + tid * 4) = dpf;
        } else {
            float a_last; { const float x = dpf[0] + dtb; const float dt = x > 20.f ? x : __logf(1.0f + __expf(x)); float v = a_neg * dt;
#define SCAN_DPP(x, ctrl, rmask) __builtin_bit_cast(float, __builtin_amdgcn_update_dpp(0, __builtin_bit_cast(int, (x)), (ctrl), (rmask), 0xF, true))
                v += SCAN_DPP(v, 0x111, 0xF); v += SCAN_DPP(v, 0x112, 0xF); v += SCAN_DPP(v, 0x114, 0xF); v += SCAN_DPP(v, 0x118, 0xF);
                v += SCAN_DPP(v, 0x142, 0xA);
                v += SCAN_DPP(v, 0x143, 0xC);
#undef SCAN_DPP
                dtv[lane] = dt; acum[lane] = v; a_last = __builtin_bit_cast(float, __builtin_amdgcn_readlane(__builtin_bit_cast(int, v), 63)); }
            *(LAS u32x4*)(lds + SC_ZS + (tid >> 3) * RS64 + (tid & 7) * 16) = vv;
            *(LAS u32x4*)(lds + SC_XS + (tid >> 3) * RS64 + (tid & 7) * 16) = pf[0];
#pragma unroll
            for (int i = 0; i < 2; ++i) { const int pc = tid + 512 * i, row = pc >> 4, c16 = pc & 15;
                *(LAS u32x4*)(lds + SC_KT + row * RS128 + c16 * 16) = pf[1 + i]; *(LAS u32x4*)(lds + SC_QT + row * RS128 + c16 * 16) = pf[3 + i]; }
            LDS_FENCE();
            { const float d = dtv[tid >> 3]; const u32x4 xv = pf[0]; u32x4 o;
#pragma unroll
              for (int e = 0; e < 4; ++e) o[e] = cvt_pk_bf16(__uint_as_float(xv[e] << 16) * d, __uint_as_float(xv[e] & 0xffff0000u) * d);
              *(LAS u32x4*)(lds + SC_VV + (tid >> 3) * RS64 + (tid & 7) * 16) = o; }
#pragma unroll
            for (int i = 0; i < 2; ++i) { const int pc = tid + 512 * i, row = pc >> 4, c16 = pc & 15; const float d = __expf(a_last - acum[row]); const u32x4 bv = pf[1 + i]; u32x4 o;
#pragma unroll
                for (int e = 0; e < 4; ++e) o[e] = cvt_pk_bf16(__uint_as_float(bv[e] << 16) * d, __uint_as_float(bv[e] & 0xffff0000u) * d);
                *(LAS u32x4*)(lds + SC_KD + row * RS128 + c16 * 16) = o; }
            if (tid >= 384) dec[tid - 384] = __expf(a_last);
        }
        __syncthreads();
        if (flags8) { if (c + 1 < 64) SCAN_PREFETCH(c + 1); __syncthreads(); continue; }
        const int ti = wid >> 1;
        bf16x8 qa[4];
#pragma unroll
        for (int s = 0; s < 4; ++s) qa[s] = frag_row(lds + SC_QT, ti * 16, RS128, 32 * s, lane);
#pragma unroll
        for (int t2 = 0; t2 < 2; ++t2) { const int tj = (wid & 1) * 2 + t2; f32x4 acc = {0.f, 0.f, 0.f, 0.f};
            if (tj <= ti) {
#pragma unroll
                for (int s = 0; s < 4; ++s) acc = MFMA16(qa[s], frag_row(lds + SC_KT, tj * 16, RS128, 32 * s, lane), acc); }
            const int j = tj * 16 + r16; const float aj = ssd ? acum[j] : 0.f;
#pragma unroll
            for (int jj = 0; jj < 4; ++jj) { const int i = ti * 16 + 4 * g4 + jj; float v = (j <= i) ? acc[jj] : 0.f; if (ssd) v *= __expf(fminf(acum[i] - aj, 0.f));
                *(LAS bf16_t*)(lds + SC_AT + i * RS64 + j * 2) = f2bf(v); } }
        {
            float dk[4];
#pragma unroll
            for (int jj = 0; jj < 4; ++jj) dk[jj] = dec[wid * 16 + 4 * g4 + jj];
            bf16x8 f3[10]; { const unsigned lb = (unsigned)(size_t)lds + (unsigned)((lane & 3) * 8), rq = (unsigned)(8 * g4 + (r16 >> 2));
                tr_batch_s3(f3, lb + rq * RS128 + wid * 32 + SC_KD, lb + rq * RS64 + SC_VV); }
#pragma unroll
            for (int tv = 0; tv < 4; ++tv) {
#pragma unroll
                for (int jj = 0; jj < 4; ++jj) Sacc[tv][jj] *= dk[jj];
#pragma unroll
                for (int ks = 0; ks < 2; ++ks) Sacc[tv] = MFMA16(f3[ks], f3[2 + tv * 2 + ks], Sacc[tv]); }
        }
        if (c + 1 < 64) SCAN_PREFETCH(c + 1);
        __syncthreads();
        {
            bf16x8 aa[2];
#pragma unroll
            for (int ks = 0; ks < 2; ++ks) aa[ks] = frag_row(lds + SC_AT, ti * 16, RS64, 32 * ks, lane);
#pragma unroll
            for (int t2 = 0; t2 < 2; ++t2) { const int tv = (wid & 1) * 2 + t2; f32x4 aA = {0.f, 0.f, 0.f, 0.f}, aI = {0.f, 0.f, 0.f, 0.f};
                bf16x8 f2[6]; { const unsigned lb = (unsigned)(size_t)lds + (unsigned)((8 * g4 + (r16 >> 2)) * RS64 + (lane & 3) * 8 + tv * 32); tr_batch_s2(f2, lb + SC_VV, lb + SC_SB); }
#pragma unroll
                for (int ks = 0; ks < 2; ++ks) aA = MFMA16(aa[ks], f2[ks], aA);
#pragma unroll
                for (int ks = 0; ks < 4; ++ks) aI = MFMA16(qa[ks], f2[2 + ks], aI);
                const int v = tv * 16 + r16;
#pragma unroll
                for (int jj = 0; jj < 4; ++jj) { const int i = ti * 16 + 4 * g4 + jj;
                    if (!ssd) { if (!dry) IN[(size_t)(t0 + i) * IN_LD + colV + v] = f2bf(aA[jj] + aI[jj]); }
                    else { const float o = aA[jj] + __expf(acum[i]) * aI[jj]; const float zz = bf2f(*(const LAS bf16_t*)(lds + SC_ZS + i * RS64 + v * 2));
                        const float xs = bf2f(*(const LAS bf16_t*)(lds + SC_XS + i * RS64 + v * 2)); if (!dry) IN[(size_t)(t0 + i) * IN_LD + colZ + v] = f2bf((o + Dh * xs) * silu_f(zz)); } } }
        }
        __syncthreads();
#pragma unroll
        for (int tv = 0; tv < 4; ++tv)
#pragma unroll
            for (int jj = 0; jj < 4; ++jj) *(LAS bf16_t*)(lds + SC_SB + (wid * 16 + 4 * g4 + jj) * RS64 + (tv * 16 + r16) * 2) = f2bf(Sacc[tv][jj]);
    }
    __syncthreads();
#undef SCAN_PREFETCH
}
__device__ __forceinline__ void phase_scan(LAS unsigned char* lds, const bool dry, const bool flags8) { for (int item = blockIdx.x; item < 256; item += gridDim.x) scan_item(item, lds, dry, flags8); }

__device__ __forceinline__ void phase_mixnorm() {
    const int tid = threadIdx.x, wid = tid >> 6, lane = tid & 63; bf16_t* IN = (bf16_t*)(PWS + WS_IN);
    const float* gg = PIN(9); const float* sg = PIN(15);
    for (int row = blockIdx.x * 8 + wid; row < T_TOK; row += gridDim.x * 8) { bf16_t* rp = IN + (size_t)row * IN_LD;
#pragma unroll
        for (int h = 0; h < 4; ++h) { const int j = h * 256 + lane * 4; const u32x2 ov = *(const u32x2*)(rp + C_V + j), rv = *(const u32x2*)(rp + C_R + j);
            float o[4] = {__uint_as_float(ov.x << 16), __uint_as_float(ov.x & 0xffff0000u), __uint_as_float(ov.y << 16), __uint_as_float(ov.y & 0xffff0000u)};
            float rr[4] = {__uint_as_float(rv.x << 16), __uint_as_float(rv.x & 0xffff0000u), __uint_as_float(rv.y << 16), __uint_as_float(rv.y & 0xffff0000u)};
            const float sq = wave_sum((o[0] * o[0] + o[1] * o[1]) + (o[2] * o[2] + o[3] * o[3])); const float rs = rsqrtf(sq * (1.0f / 256.0f) + 1e-6f);
            const f32x4 gv = *(const f32x4*)(gg + j);
            u32x2 w; w.x = cvt_pk_bf16(o[0] * rs * gv[0] * silu_f(rr[0]), o[1] * rs * gv[1] * silu_f(rr[1])); w.y = cvt_pk_bf16(o[2] * rs * gv[2] * silu_f(rr[2]), o[3] * rs * gv[3] * silu_f(rr[3]));
            *(u32x2*)(rp + C_R + j) = w; }
#pragma unroll
        for (int g = 0; g < 2; ++g) { const int j = g * 512 + lane * 8; const u32x4 yv = *(const u32x4*)(rp + C_Z + j); float y[8];
#pragma unroll
            for (int e = 0; e < 4; ++e) { y[2 * e] = __uint_as_float(yv[e] << 16); y[2 * e + 1] = __uint_as_float(yv[e] & 0xffff0000u); }
            float sq = 0.f;
#pragma unroll
            for (int e = 0; e < 8; ++e) sq += y[e] * y[e];
            sq = wave_sum(sq); const float rs = rsqrtf(sq * (1.0f / 512.0f) + 1e-6f);
            const f32x4 g0 = *(const f32x4*)(sg + j), g1 = *(const f32x4*)(sg + j + 4);
            u32x4 w; w.x = cvt_pk_bf16(y[0] * rs * g0[0], y[1] * rs * g0[1]); w.y = cvt_pk_bf16(y[2] * rs * g0[2], y[3] * rs * g0[3]); w.z = cvt_pk_bf16(y[4] * rs * g1[0], y[5] * rs * g1[1]); w.w = cvt_pk_bf16(y[6] * rs * g1[2], y[7] * rs * g1[3]);
            *(u32x4*)(rp + C_Z + j) = w; } }
}

__device__ __forceinline__ void phase_d2() {
    const int tid = threadIdx.x, wid = tid >> 6, lane = tid & 63;
    const float* raw = (const float*)(PWS + WS_RAW1); bf16_t* QL = (bf16_t*)(PWS + WS_QLAT); bf16_t* KV = (bf16_t*)(PWS + WS_KV); bf16_t* KI = (bf16_t*)(PWS + WS_KIDX); float* WI = (float*)(PWS + WS_WIDX);
    const float* qg = PIN(18); const float* kg = PIN(21); const float* lg = PIN(26); const float* lb = PIN(27);
    for (int row = blockIdx.x * 8 + wid; row < T_TOK; row += gridDim.x * 8) { const float* rp = raw + (size_t)row * 512;
        { const f32x4 v = *(const f32x4*)(rp + lane * 4); const float sq = wave_sum((v[0] * v[0] + v[1] * v[1]) + (v[2] * v[2] + v[3] * v[3])); const float rs = rsqrtf(sq * (1.0f / 256.0f) + 1e-6f);
          const f32x4 g = *(const f32x4*)(qg + lane * 4); u32x2 w; w.x = cvt_pk_bf16(v[0] * rs * g[0], v[1] * rs * g[1]); w.y = cvt_pk_bf16(v[2] * rs * g[2], v[3] * rs * g[3]);
          *(u32x2*)(QL + (size_t)row * 256 + lane * 4) = w; }
        { const float a = rp[256 + lane * 2], b = rp[256 + lane * 2 + 1]; const float sq = wave_sum(a * a + b * b); const float rs = rsqrtf(sq * (1.0f / 128.0f) + 1e-6f);
          *(unsigned*)(KV + (size_t)row * 128 + lane * 2) = cvt_pk_bf16(a * rs * kg[lane * 2], b * rs * kg[lane * 2 + 1]); }
        { const float a = rp[384 + lane]; const float mu = wave_sum(a) * (1.0f / 64.0f); const float d = a - mu; const float var = wave_sum(d * d) * (1.0f / 64.0f);
          KI[(size_t)row * 64 + lane] = f2bf(d * rsqrtf(var + 1e-6f) * lg[lane] + lb[lane]); }
        if (lane < 16) WI[(size_t)row * 16 + lane] = rp[448 + lane] * 0.03125f; }
}

constexpr int DS_LIST = 131072, DS_RELB = 139264, DS_BUCK = 141312, DS_QIP = 141824, DS_WIP = 158208;
__device__ __forceinline__ unsigned f2key(float f) { const unsigned u = __float_as_uint(f); return (u & 0x80000000u) ? ~u : (u | 0x80000000u); }
template <int NR> __device__ __forceinline__ unsigned bisect_thr(const unsigned (&r)[NR], int nact, int target) {
    unsigned thr = 0u;
    for (int bit = 31; bit >= 0; --bit) { const unsigned trial = thr | (1u << bit); int cnt = 0; int na = nact; asm volatile("" : "+s"(na));
#pragma unroll
        for (int j4 = 0; j4 < NR / 4; ++j4) { if (j4 * 4 < na) {
#pragma unroll
            for (int e = 0; e < 4; ++e) cnt += __popcll(__ballot(r[j4 * 4 + e] >= trial)); } }
        if (cnt >= target) thr = trial;
        if (cnt == target) break; }
    return thr;
}
template <int NR> __device__ __forceinline__ int count_ge(const unsigned (&r)[NR], int nact, unsigned t) {
    int cnt = 0; int na = nact; asm volatile("" : "+s"(na));
#pragma unroll
    for (int j4 = 0; j4 < NR / 4; ++j4) { if (j4 * 4 < na) {
#pragma unroll
        for (int e = 0; e < 4; ++e) cnt += __popcll(__ballot(r[j4 * 4 + e] >= t)); } }
    return cnt;
}
__device__ __forceinline__ void phase_dsa(LAS unsigned char* lds, const int flags) {
    const int tid = threadIdx.x, wid = __builtin_amdgcn_readfirstlane(tid >> 6), lane = tid & 63, r16 = lane & 15, g4 = lane >> 4;
    const bf16_t* Q = (const bf16_t*)(PWS + WS_Q); bf16_t* OL = (bf16_t*)(PWS + WS_OLAT); const bf16_t* QI = (const bf16_t*)(PWS + WS_QIDX); const bf16_t* KV = (const bf16_t*)(PWS + WS_KV);
    const bf16_t* KI = (const bf16_t*)(PWS + WS_KIDX); const float* WI = (const float*)(PWS + WS_WIDX);
    LAS float* relb = (LAS float*)(lds + DS_RELB); LAS int* buck = (LAS int*)(lds + DS_BUCK);
    relb[tid] = PIN(29)[tid];
    if (tid < 128) { int bk = tid; if (tid >= 16) { const float relf = (float)tid; int lg = 16 + (int)(logf(relf / 16.0f) / 2.0794415416798357f * 16.0f); bk = lg < 31 ? lg : 31; } buck[tid] = bk; }
    __syncthreads();
    LAS unsigned* myslab = (LAS unsigned*)(lds + wid * 16384);
    LAS unsigned* mylist = (LAS unsigned*)(lds + DS_LIST + wid * 1024);
    LAS unsigned char* kvst = lds + wid * 16384;
    LAS unsigned char* pst = lds + wid * 16384 + 8704;
#define DSA_PREFETCH(uu) do { const int ui_ = (uu) >> 8, ub_ = (uu) & 255, b_ = ub_ & 7, xx_ = ub_ >> 3, ti_ = ui_ * 32 + ((ui_ & 1) ? 31 - xx_ : xx_); const int tk_ = b_ * SEQ + ti_ * 8; \
        _Pragma("unroll") for (int i_ = 0; i_ < 2; ++i_) __builtin_amdgcn_global_load_lds((const unsigned*)(QI + (size_t)(tk_ + wid) * 1024 + (i_ * 64 + lane) * 8), (LAS unsigned*)(lds + DS_QIP + wid * 2048 + i_ * 1024), 16, 0, 0); \
        if (wid == 0) __builtin_amdgcn_global_load_lds((const unsigned*)(WI + (size_t)tk_ * 16 + lane * 4), (LAS unsigned*)(lds + DS_WIP), 16, 0, 0); } while (0)
    if ((int)blockIdx.x < 4096) DSA_PREFETCH((int)blockIdx.x);
    asm volatile("s_waitcnt vmcnt(0)" ::: "memory");
    __syncthreads();
    for (int u = blockIdx.x; u < 4096; u += gridDim.x) {
        const int ui = u >> 8, ublk = u & 255, b = ublk & 7, xx = ublk >> 3, ti = ui * 32 + ((ui & 1) ? 31 - xx : xx);
        const int q0 = ti * 8, tok0 = b * SEQ + q0, nkt = (q0 + 8 + 15) >> 4, n16 = nkt * 16;
        {
            bf16x8 qa[8][2]; f32x4 wq[8];
#pragma unroll
            for (int qq = 0; qq < 8; ++qq) { const LAS unsigned char* qp = lds + DS_QIP + qq * 2048 + (r16 * 64 + 8 * g4) * 2;
                qa[qq][0] = *(const LAS bf16x8*)qp; qa[qq][1] = *(const LAS bf16x8*)(qp + 64); wq[qq] = *(const LAS f32x4*)(lds + DS_WIP + qq * 64 + g4 * 16); }
            const int qsel = __ffs((int)rows4_total(1.0f, 2.0f, 4.0f, 8.0f)) - 3;
            const int myq0 = q0 + qsel, myq1 = q0 + 4 + qsel;
            LAS unsigned* slab0 = (LAS unsigned*)(lds + qsel * 16384); LAS unsigned* slab1 = (LAS unsigned*)(lds + (4 + qsel) * 16384);
            const bf16_t* kbase = KI + (size_t)(b * SEQ + r16) * 64 + 8 * g4;
            bf16x8 kc[4][2], kn[4][2];
#pragma unroll
            for (int j = 0; j < 4; ++j) { int kt = wid + 8 * j; kt = kt < nkt ? kt : nkt - 1; const bf16_t* kp = kbase + (size_t)kt * 1024; kn[j][0] = *(const bf16x8*)kp; kn[j][1] = *(const bf16x8*)(kp + 32); }
            for (int kt0 = wid; kt0 < nkt; kt0 += 32) {
#pragma unroll
                for (int j = 0; j < 4; ++j) { kc[j][0] = kn[j][0]; kc[j][1] = kn[j][1]; }
                if (kt0 + 32 < nkt) {
#pragma unroll
                    for (int j = 0; j < 4; ++j) { int kt = kt0 + 32 + 8 * j; kt = kt < nkt ? kt : nkt - 1; const bf16_t* kp = kbase + (size_t)kt * 1024; kn[j][0] = *(const bf16x8*)kp; kn[j][1] = *(const bf16x8*)(kp + 32); } }
#pragma unroll
                for (int j = 0; j < 4; ++j) { const int kt = kt0 + 8 * j;
                    if (kt < nkt) { const int key = kt * 16 + r16;
                        f32x4 acc[8]; float sp[8];
#pragma unroll
                        for (int qq = 0; qq < 8; ++qq) acc[qq] = MFMA16(qa[qq][0], kc[j][0], ((f32x4){0.f, 0.f, 0.f, 0.f}));
#pragma unroll
                        for (int qq = 0; qq < 8; ++qq) acc[qq] = MFMA16(qa[qq][1], kc[j][1], acc[qq]);
#pragma unroll
                        for (int qq = 0; qq < 8; ++qq) {
                            const float r0 = __int_as_float(max(__float_as_int(acc[qq][0]), 0)), r1 = __int_as_float(max(__float_as_int(acc[qq][1]), 0));
                            const float r2 = __int_as_float(max(__float_as_int(acc[qq][2]), 0)), r3 = __int_as_float(max(__float_as_int(acc[qq][3]), 0));
                            sp[qq] = (wq[qq][0] * r0 + wq[qq][1] * r1) + (wq[qq][2] * r2 + wq[qq][3] * r3); }
                        const float t0s = rows4_total(sp[0], sp[1], sp[2], sp[3]) + 0.0f, t1s = rows4_total(sp[4], sp[5], sp[6], sp[7]) + 0.0f;
                        slab0[key] = (key <= myq0) ? f2key(t0s) : 0u; slab1[key] = (key <= myq1) ? f2key(t1s) : 0u; } }
            }
        }
        __syncthreads();
        if (u + (int)gridDim.x < 4096) DSA_PREFETCH(u + (int)gridDim.x);
        if (flags & 2) { asm volatile("s_waitcnt vmcnt(0)" ::: "memory"); __syncthreads(); continue; }
        const int qpos = q0 + wid, n = qpos + 1; int nsel;
        if (n <= 256) { nsel = n; for (int i = lane; i < n; i += 64) mylist[i] = (unsigned)i; }
        else {
            unsigned sv[64]; int nvA = n16; asm volatile("" : "+s"(nvA));
#pragma unroll
            for (int j = 0; j < 64; ++j) { sv[j] = 0u; if (j * 64 < nvA) { const int idx = j * 64 + lane; const unsigned t = myslab[idx]; sv[j] = idx < nvA ? t : 0u; } }
            const int nregs = (n16 + 63) >> 6;
            const unsigned long long lt = (1ull << lane) - 1ull;
            bool done = false;
            if (n16 > 1024) {
                unsigned sub[8];
#pragma unroll
                for (int i = 0; i < 8; ++i) sub[i] = sv[8 * i];
                const unsigned tS = bisect_thr<8>(sub, (nregs + 7) >> 3, 48);
                const int c = count_ge<64>(sv, nregs, tS);
                if (c >= 256 && c <= 1024) {
                    LAS unsigned* candK = myslab; LAS unsigned* candI = myslab + 1024;
                    int npos = 0; int nvC = n16; asm volatile("" : "+s"(nvC));
#pragma unroll
                    for (int jr = 0; jr < 64; ++jr) { if (jr * 64 < nvC) { const unsigned kv = sv[jr]; const bool in = kv >= tS; const unsigned long long m = __ballot(in);
                        const int pos = npos + __popcll(m & lt); if (in) { candK[pos] = kv; candI[pos] = (unsigned)(jr * 64 + lane); } npos += __popcll(m); } }
                    LDS_FENCE();
                    unsigned ck[16]; const int ncr = (c + 63) >> 6;
#pragma unroll
                    for (int jr = 0; jr < 16; ++jr) { ck[jr] = 0u; if (jr < ncr) { const int idx = jr * 64 + lane; const unsigned t = candK[idx]; ck[jr] = idx < c ? t : 0u; } }
                    const unsigned thr = bisect_thr<16>(ck, ncr, 256);
                    int cgt = 0; { int na = ncr; asm volatile("" : "+s"(na));
#pragma unroll
                        for (int jr = 0; jr < 16; ++jr) { if (jr < na) cgt += __popcll(__ballot(ck[jr] > thr)); } }
                    const int need_eq = 256 - cgt; int nout = 0, eq_seen = 0; int nb = ncr; asm volatile("" : "+s"(nb));
#pragma unroll
                    for (int jr = 0; jr < 16; ++jr) { if (jr < nb) { const unsigned kv = ck[jr]; const bool gt = kv > thr, eq = kv == thr && (jr * 64 + lane) < c;
                        const unsigned long long eqm = __ballot(eq);
                        const bool sel = gt || (eq && (eq_seen + __popcll(eqm & lt)) < need_eq);
                        const unsigned long long sm = __ballot(sel); const int pos = nout + __popcll(sm & lt);
                        if (sel && pos < 256) mylist[pos] = candI[jr * 64 + lane];
                        nout += __popcll(sm); eq_seen += __popcll(eqm); } }
                    done = true;
                }
            }
            if (!done) {
                const unsigned thr = bisect_thr<64>(sv, nregs, 256);
                int cgt = 0; int nvB = n16; asm volatile("" : "+s"(nvB));
#pragma unroll
                for (int j4 = 0; j4 < 16; ++j4) { if (j4 * 256 < nvB) {
#pragma unroll
                    for (int e = 0; e < 4; ++e) cgt += __popcll(__ballot(sv[j4 * 4 + e] > thr)); } }
                const int need_eq = 256 - cgt; int nout = 0, eq_seen = 0; int nvC = n16; asm volatile("" : "+s"(nvC));
#pragma unroll
                for (int jr = 0; jr < 64; ++jr) { if (jr * 64 < nvC) { const unsigned kv = sv[jr]; const bool gt = kv > thr, eq = kv == thr;
                    const unsigned long long eqm = __ballot(eq);
                    const bool sel = gt || (eq && (eq_seen + __popcll(eqm & lt)) < need_eq);
                    const unsigned long long sm = __ballot(sel); const int pos = nout + __popcll(sm & lt);
                    if (sel && pos < 256) mylist[pos] = (unsigned)(jr * 64 + lane);
                    nout += __popcll(sm); eq_seen += __popcll(eqm); } }
            }
            nsel = 256;
        }
        LDS_FENCE();
        if (!(flags & 4)) {
            const int tq = tok0 + wid; bf16x8 qf[4];
#pragma unroll
            for (int s = 0; s < 4; ++s) qf[s] = *(const bf16x8*)(Q + (size_t)tq * 2048 + r16 * 128 + 32 * s + 8 * g4);
            f32x4 O[8]; float mrun[4], lrun[4];
#pragma unroll
            for (int i = 0; i < 8; ++i) O[i] = (f32x4){0.f, 0.f, 0.f, 0.f};
#pragma unroll
            for (int i = 0; i < 4; ++i) { mrun[i] = -INFINITY; lrun[i] = 0.f; }
            const int nch = (nsel + 31) >> 5;
            const bf16_t* kvb = KV + (size_t)(b * SEQ) * 128 + (lane & 15) * 8;
            u32x4 g0[8], g1[8];
#pragma unroll
            for (int i = 0; i < 8; ++i) { const int row = (lane >> 4) + 4 * i; const int kidx = row < nsel ? (int)mylist[row] : 0; g0[i] = *(const u32x4*)(kvb + (size_t)kidx * 128); }
#pragma unroll
            for (int i = 0; i < 8; ++i) { const int row = 32 + (lane >> 4) + 4 * i; const int kidx = row < nsel ? (int)mylist[row] : 0; g1[i] = *(const u32x4*)(kvb + (size_t)kidx * 128); }
            for (int ch = 0; ch < nch; ++ch) {
#pragma unroll
                for (int i = 0; i < 8; ++i) { const int row = (lane >> 4) + 4 * i; *(LAS u32x4*)(kvst + row * 272 + (lane & 15) * 16) = g0[i]; g0[i] = g1[i]; }
                if (ch + 2 < nch) {
#pragma unroll
                    for (int i = 0; i < 8; ++i) { const int row = (ch + 2) * 32 + (lane >> 4) + 4 * i; const int kidx = row < nsel ? (int)mylist[row] : 0; g1[i] = *(const u32x4*)(kvb + (size_t)kidx * 128); } }
                LDS_FENCE();
                f32x4 S[2];
#pragma unroll
                for (int t2 = 0; t2 < 2; ++t2) { f32x4 acc = {0.f, 0.f, 0.f, 0.f};
#pragma unroll
                    for (int s = 0; s < 4; ++s) acc = MFMA16(qf[s], frag_row(kvst, t2 * 16, 272, 32 * s, lane), acc);
                    const int kk = ch * 32 + t2 * 16 + r16; const bool valid = kk < nsel; const int skey = valid ? (int)mylist[kk] : 0; const int rel = qpos - skey;
                    const int bk = rel < 128 ? buck[rel < 0 ? 0 : rel] : 31; const f32x4 bias = *(const LAS f32x4*)(relb + bk * 16 + 4 * g4);
#pragma unroll
                    for (int jj = 0; jj < 4; ++jj) S[t2][jj] = valid ? acc[jj] + bias[jj] : -INFINITY; }
                float alpha[4];
#pragma unroll
                for (int jj = 0; jj < 4; ++jj) { const float cm = row16_max(fmaxf(S[0][jj], S[1][jj]));
                    const float mn = fmaxf(mrun[jj], cm); alpha[jj] = __expf(mrun[jj] - mn); mrun[jj] = mn;
                    const float p0 = __expf(S[0][jj] - mn), p1 = __expf(S[1][jj] - mn); lrun[jj] = lrun[jj] * alpha[jj] + p0 + p1;
                    *(LAS bf16_t*)(pst + (4 * g4 + jj) * 80 + r16 * 2) = f2bf(p0); *(LAS bf16_t*)(pst + (4 * g4 + jj) * 80 + (16 + r16) * 2) = f2bf(p1); }
                LDS_FENCE();
                const bf16x8 pa = *(const LAS bf16x8*)(pst + r16 * 80 + g4 * 16);
                bf16x8 vf[8]; tr_batch_pv(vf, (unsigned)(size_t)kvst + (unsigned)((8 * g4 + (r16 >> 2)) * 272 + (lane & 3) * 8));
#pragma unroll
                for (int ct = 0; ct < 8; ++ct) {
#pragma unroll
                    for (int jj = 0; jj < 4; ++jj) O[ct][jj] *= alpha[jj];
                    O[ct] = MFMA16(pa, vf[ct], O[ct]); }
            }
#pragma unroll
            for (int jj = 0; jj < 4; ++jj) { const float inv = 1.0f / row16_sum(lrun[jj]);
#pragma unroll
                for (int ct = 0; ct < 8; ++ct) OL[(size_t)tq * 2048 + (4 * g4 + jj) * 128 + ct * 16 + r16] = f2bf(O[ct][jj] * inv); }
        }
        asm volatile("s_waitcnt vmcnt(0)" ::: "memory");
        __syncthreads();
    }
#undef DSA_PREFETCH
}

__device__ __forceinline__ void phase_final() {
    const float* ss = (const float*)(PWS + WS_SS); const float* g = PIN(30); float* out = POUT; const bf16_t* XB = (const bf16_t*)(PWS + WS_XB);
    for (size_t i = (size_t)blockIdx.x * 512 + threadIdx.x; i < (size_t)T_TOK * 256; i += (size_t)gridDim.x * 512) { const int row = (int)(i >> 8), c = (int)(i & 255) * 4;
        const float rs = row_rstd(ss, row); const u32x2 q = *(const u32x2*)(XB + (size_t)row * DM + c); const f32x4 gv = *(const f32x4*)(g + c);
        f32x4 v; v[0] = __uint_as_float(q.x << 16); v[1] = __uint_as_float(q.x & 0xffff0000u); v[2] = __uint_as_float(q.y << 16); v[3] = __uint_as_float(q.y & 0xffff0000u);
        *(f32x4*)(out + (size_t)row * DM + c) = v * rs * gv; }
}

#define XB_TMO      128
#define XB_XCNT(j)  (256  + 64 * (j))
#define XB_XSUB(j)  (1280 + 64 * (j))
#define XB_XGEN(j)  (2304 + 64 * (j))
#define XB_TOP      3328
#define XB_TOPGEN   3392
#define XCD_BAR_WORDS 3456
#define XB_SPIN_CAP (1u << 18)

__device__ __forceinline__ unsigned xb_ld(unsigned* p)              { return __hip_atomic_load(p, __ATOMIC_RELAXED, __HIP_MEMORY_SCOPE_AGENT); }
__device__ __forceinline__ unsigned xb_add(unsigned* p, unsigned v) { return __hip_atomic_fetch_add(p, v, __ATOMIC_RELAXED, __HIP_MEMORY_SCOPE_AGENT); }
__device__ __forceinline__ unsigned xb_xcc_id() { return (unsigned)__builtin_amdgcn_s_getreg((3 << 11) | 20) & 0xFu; }
#define XB_SPIN(cond, bar) do { unsigned _sp = 0; while (cond) { __builtin_amdgcn_s_sleep(1); \
    if ((++_sp & 255u) == 0u) { if (xb_ld(&(bar)[XB_TMO])) break; if (_sp > XB_SPIN_CAP) { atomicAdd(&(bar)[XB_TMO], 1u); break; } } } } while (0)

struct XcdBarrier {
    unsigned* bar; unsigned x;
    volatile LAS unsigned* st;
};

__device__ __forceinline__ XcdBarrier xcd_barrier_post(unsigned* bar, volatile LAS unsigned* st) {
    XcdBarrier b; b.bar = bar; b.x = xb_xcc_id(); b.st = st;
    if (threadIdx.x == 0) (void)xb_add(&bar[XB_XCNT(b.x)], 1u);
    return b;
}
__device__ __forceinline__ void xcd_barrier_complete(unsigned* bar, unsigned x, unsigned& nloc, unsigned& nx) {
    const unsigned G = gridDim.x * gridDim.y * gridDim.z;
    unsigned sum, cnt, mine, sp = 0u;
    for (;;) {
        sum = 0u; cnt = 0u; mine = 0u;
#pragma unroll
        for (unsigned j = 0; j < 16; ++j) { const unsigned c = xb_ld(&bar[XB_XCNT(j)]); sum += c; cnt += (c > 0u) ? 1u : 0u; mine = (j == x) ? c : mine; }
        if (sum == G) break;
        __builtin_amdgcn_s_sleep(1);
        if ((++sp & 255u) == 0u) { if (xb_ld(&bar[XB_TMO])) break; if (sp > XB_SPIN_CAP) { atomicAdd(&bar[XB_TMO], 1u); break; } }
    }
    nloc = mine > 0u ? mine : 1u; nx = cnt > 0u ? cnt : 1u;
}

__device__ __forceinline__ void xcd_barrier(const XcdBarrier& b) {
    asm volatile("s_waitcnt vmcnt(0)" ::: "memory");
    __syncthreads();
    if (threadIdx.x == 0) {
        unsigned* bar = b.bar;
        __builtin_amdgcn_s_waitcnt(0);
        unsigned nloc = b.st[0], nx = b.st[1];
        if (nloc == 0u) { xcd_barrier_complete(bar, b.x, nloc, nx); b.st[0] = nloc; b.st[1] = nx; }
        const unsigned old = xb_add(&bar[XB_XSUB(b.x)], 1u);
        const unsigned gen = old / nloc;
        if (old + 1u == (gen + 1u) * nloc) {
            __builtin_amdgcn_fence(__ATOMIC_RELEASE, "agent");
            asm volatile("s_waitcnt vmcnt(0)" ::: "memory");
            const unsigned og = xb_add(&bar[XB_TOP], 1u);
            const unsigned tg = og / nx;
            if (og + 1u == (tg + 1u) * nx) xb_add(&bar[XB_TOPGEN], 1u);
            else XB_SPIN(xb_ld(&bar[XB_TOPGEN]) == tg, bar);
            __builtin_amdgcn_fence(__ATOMIC_ACQUIRE, "agent");
            xb_add(&bar[XB_XGEN(b.x)], 1u);
            asm volatile("s_waitcnt vmcnt(0)" ::: "memory");
        } else {
            XB_SPIN(xb_ld(&bar[XB_XGEN(b.x)]) == gen, bar);
            __builtin_amdgcn_fence(__ATOMIC_ACQUIRE, "agent");
            asm volatile("s_waitcnt vmcnt(0)" ::: "memory");
        }
    }
    __syncthreads();
}


constexpr int N_PHASES = 20;
__global__ void __launch_bounds__(512, 2) fwd_mega(Params p) {
    extern __shared__ __attribute__((aligned(16))) unsigned char shm[];
    LAS unsigned char* lds = (LAS unsigned char*)shm;
    cg::grid_group grid = cg::this_grid();
    const int ph_lo = PARG_I(264), ph_hi = PARG_I(268), flags = PARG_I(272);
    volatile LAS unsigned* xst = (volatile LAS unsigned*)(lds + LDS_BYTES - 16);
    if (threadIdx.x == 0) { xst[0] = 0u; xst[1] = 0u; xst[2] = 0u; xst[3] = 0u; }
    __syncthreads();
    const XcdBarrier xbar = xcd_barrier_post((unsigned*)(PWS + WS_BAR), xst);
#define ws PWS
#define gXB ((bf16_t*)(PWS + WS_XB))
#define gSS ((float*)(PWS + WS_SS))
#define gACT ((bf16_t*)(PWS + WS_ACT))
#define gIN ((bf16_t*)(PWS + WS_IN))
#ifndef KEEPMASK
#define KEEPMASK 0xFFFFFFFFu
#endif
#define PHASE(n, ...) if (((KEEPMASK >> (n)) & 1u) && ph_lo <= (n) && (n) < ph_hi) { __VA_ARGS__; if ((n) + 1 < ph_hi) xcd_barrier(xbar); }
#define GU_PHASE(n, lf) PHASE(n, { EpiGU E; E.act = gACT; E.ss = gSS; E.cpm = -1; run_gemm(lds, gXB, 1024, (const bf16_t*)(ws + W_GU + (lf) * W_GU_SZ), T_TOK, 5632, 1024, E, 16); })
#define DN_PHASE(n, lf, RES) PHASE(n, { EpiRes E; E.res32 = (RES); E.XB = gXB; E.ss = gSS; run_gemm(lds, gACT, 2816, (const bf16_t*)(ws + W_D + (lf) * W_D_SZ), T_TOK, 1024, 2816, E); })
    if (ph_lo == 100) { for (int i = 0; i < 20; ++i) grid.sync(); }
    PHASE(0, phase_prologue(lds))
    GU_PHASE(1, 0)
    DN_PHASE(2, 0, PIN(0))
    PHASE(3, { EpiIn E; E.IN = gIN; E.small = (float*)(ws + WS_SMALL); E.ss = gSS; E.cpm = -1; run_gemm(lds, gXB, 1024, (const bf16_t*)(ws + W_IN), T_TOK, 5632, 1024, E, 16); phase_small_proj(); })
    PHASE(4, phase_prep(lds))
    PHASE(5, phase_scan(lds, (flags & 1) != 0, (flags & 8) != 0))
    PHASE(6, phase_mixnorm())
    PHASE(7, { EpiRes E; E.res32 = nullptr; E.XB = gXB; E.ss = gSS; run_gemm(lds, gIN + C_R, IN_LD, (const bf16_t*)(ws + W_OUT), T_TOK, 1024, 2048, E); })
    GU_PHASE(8, 1)
    DN_PHASE(9, 1, (const float*)nullptr)
    GU_PHASE(10, 2)
    DN_PHASE(11, 2, (const float*)nullptr)
    if (gridDim.x == 256) {
        PHASE(12, { EpiD1F E; E.ss = gSS; E.QL = (bf16_t*)(ws + WS_QLAT); E.KV = (bf16_t*)(ws + WS_KV); E.KI = (bf16_t*)(ws + WS_KIDX); E.WI = (float*)(ws + WS_WIDX);
            E.qg = PIN(18); E.kg = PIN(21); E.lg = PIN(26); E.lb = PIN(27); E.cpm = -1; run_gemm(lds, gXB, 1024, (const bf16_t*)(ws + W_D1), T_TOK, 512, 1024, E); })
    } else {
        PHASE(12, { EpiD1 E; E.raw = (float*)(ws + WS_RAW1); E.ss = gSS; E.cpm = -1; run_gemm(lds, gXB, 1024, (const bf16_t*)(ws + W_D1), T_TOK, 512, 1024, E); })
        PHASE(13, phase_d2())
    }
    PHASE(14, { EpiD3 E; E.Q = (bf16_t*)(ws + WS_Q); E.QI = (bf16_t*)(ws + WS_QIDX); run_gemm(lds, (const bf16_t*)(ws + WS_QLAT), 256, (const bf16_t*)(ws + W_D3), T_TOK, 3072, 256, E); })
    PHASE(15, phase_dsa(lds, flags))
    PHASE(16, { EpiRes E; E.res32 = nullptr; E.XB = gXB; E.ss = gSS; run_gemm(lds, (const bf16_t*)(ws + WS_OLAT), 2048, (const bf16_t*)(ws + W_C), T_TOK, 1024, 2048, E); })
    GU_PHASE(17, 3)
    DN_PHASE(18, 3, (const float*)nullptr)
    PHASE(19, phase_final())
#undef ws
}

extern "C" void kernel_launch(void* const* d_in, const int* in_sizes, int n_in, void* d_out, int out_size, void* d_ws, size_t ws_size, hipStream_t stream) {
    static int grid = 0;
    if (grid == 0) {
        int dev = 0, cus = 0, per_cu = 0;
        hipGetDevice(&dev); hipDeviceGetAttribute(&cus, hipDeviceAttributeMultiprocessorCount, dev);
        hipFuncSetAttribute((const void*)fwd_mega, hipFuncAttributeMaxDynamicSharedMemorySize, LDS_BYTES);
        hipOccupancyMaxActiveBlocksPerMultiprocessor(&per_cu, (const void*)fwd_mega, 512, LDS_BYTES);
        (void)hipGetLastError();
        if (per_cu < 1) per_cu = 1;
        grid = cus > 0 ? cus : 256;
        if (n_in != 31 || ws_size < WS_END) fprintf(stderr, "kernel_launch: unexpected n_in %d / ws_size %zu (need %zu)\n", n_in, ws_size, (size_t)WS_END);
    }
#ifndef PROBE_SEQ
#define PROBE_SEQ {0, N_PHASES, 0}
#endif
    static const int seq[][3] = { PROBE_SEQ };
    for (unsigned li = 0; li < sizeof(seq) / sizeof(seq[0]); ++li) {
        Params p{};
        for (int i = 0; i < 31; ++i) p.in[i] = (const float*)d_in[i];
        p.out = (float*)d_out; p.ws = (unsigned char*)d_ws; p.ph_lo = seq[li][0]; p.ph_hi = seq[li][1]; p.flags = seq[li][2];
        (void)hipMemsetAsync((unsigned char*)d_ws + WS_BAR, 0, XCD_BAR_WORDS * sizeof(unsigned), stream);
        void* args[] = {&p};
        hipError_t e = hipLaunchCooperativeKernel((const void*)fwd_mega, dim3(grid), dim3(512), args, LDS_BYTES, stream);
        if (e != hipSuccess) fprintf(stderr, "cooperative launch failed: %s (grid %d)\n", hipGetErrorString(e), grid);
    }
}
```

```cpp
#include <hip/hip_runtime.h>
#include <hip/hip_cooperative_groups.h>
#include <cstdio>
#include <cstdint>
namespace cg = cooperative_groups;

#include <hip/hip_runtime.h>
namespace pg8 {
#define PG8_LAS __attribute__((address_space(3)))
typedef unsigned short bf16_t;
typedef short bf16x8 __attribute__((ext_vector_type(8)));
typedef float f32x4 __attribute__((ext_vector_type(4)));
typedef unsigned u32x4 __attribute__((ext_vector_type(4)));
constexpr int BM = 256, BK = 64, HALF = 128, HTB = HALF * BK * 2  , STAGE_BYTES = 8 * HTB, NXCD = 8, WGM = 8;

__host__ __device__ __forceinline__ int lds_byte(int r, int c) { const int st = (r >> 4) * 2 + (c >> 5), rr = r & 15, cc = c & 31, ob = rr * 64 + cc * 2; return st * 1024 + (ob ^ (((ob >> 9) & 1) << 5)); }
__host__ __device__ __forceinline__ void stage_rc(int b, int& R, int& C) { const int st = b / 1024, sb = b % 1024, swz = sb ^ (((sb >> 9) & 1) << 5); R = (st >> 1) * 16 + swz / 64; C = (st & 1) * 32 + (swz % 64) / 2; }
__host__ __device__ __forceinline__ int perm32(int rho) { const int n = rho >> 4, i = rho & 15; return 8 * (i >> 2) + 4 * n + (i & 3); }

struct Unit { int pm, pn; };
struct Gemm { const bf16_t* A; const bf16_t* Bt; int M, N, K, lda; };

struct StaticOrder {
    int nM, nN, nwg, G, c, wgm;
    __host__ __device__ void init(int M, int N, int G_, int c_, int wgm_ = WGM) { nM = M / BM; nN = N / BM; nwg = nM * nN; G = G_; c = c_; wgm = wgm_; }
    __host__ __device__ bool next(int i, Unit& u) const {
        const long L = (long)i * G + c; if (L >= nwg) return false;
        int wgid = (int)L; { const int q = nwg / NXCD, r = nwg % NXCD, xcd = wgid % NXCD, off = wgid / NXCD; wgid = (xcd < r ? xcd * (q + 1) : r * (q + 1) + (xcd - r) * q) + off; }
        const int nig = wgm * nN, gid = wgid / nig, fm = gid * wgm, gsz = (nM - fm) < wgm ? (nM - fm) : wgm;
        u.pm = fm + ((wgid % nig) % gsz); u.pn = (wgid % nig) / gsz; return true;
    }
    __device__ __forceinline__ void a_ready(const Unit&) const {}
    __device__ __forceinline__ void done(const Unit&) const {}
};

typedef __bf16 bf16n2 __attribute__((ext_vector_type(2))); typedef float f32n2 __attribute__((ext_vector_type(2)));
__device__ __forceinline__ unsigned cvt_pk_bf16(float lo, float hi) { const bf16n2 h = __builtin_convertvector((f32n2){lo, hi}, bf16n2); return __builtin_bit_cast(unsigned, h); }

template <class Epi, class Sched>
__device__ __forceinline__ void gemm_phase(PG8_LAS unsigned char* lds, const Gemm g, const Sched& S, const Epi& E) {
    const int tid = threadIdx.x, wid = __builtin_amdgcn_readfirstlane(tid >> 6), lane = tid & 63, wr = wid >> 2, wc = wid & 3, fr = lane & 15, fq = lane >> 4;
    const int K = g.K, nt = K / BK;
    unsigned voffA[2], voffB[2];
#pragma unroll
    for (int i = 0; i < 2; ++i) { int R, C; stage_rc(tid * 16 + i * 8192, R, C); const int Rb = Epi::PERM ? ((R & ~31) + perm32(R & 31)) : R;
        voffA[i] = (unsigned)(R * g.lda + C) * 2u; voffB[i] = (unsigned)(Rb * K + C) * 2u; }
    const size_t kstep = (size_t)(BK * 2);
    const size_t hstep = (size_t)HALF * K * 2;
    const size_t hstepA = (size_t)HALF * g.lda * 2, tstepA = 2 * hstepA;
    const size_t tstep = 2 * hstep;
    const unsigned ldsw = (unsigned)wid * 1024u;
    const int aoff = lds_byte(wr * 64 + fr, fq * 8), boff = lds_byte(wc * 32 + fr, fq * 8);
#define PG8_SA(b, h) (((b) * 2 + (h)) * HTB)
#define PG8_SB(b, h) ((4 + (b) * 2 + (h)) * HTB)
#define PG8_STAGE(bufoff, gbase, voff) do { _Pragma("unroll") for (int _i = 0; _i < 2; ++_i) \
        __builtin_amdgcn_global_load_lds((const unsigned*)((const char*)(gbase) + (voff)[_i]), (PG8_LAS unsigned*)(lds + (bufoff) + ldsw + _i * 8192), 16, 0, 0); } while (0)
#define PG8_LDA(dst, b, h) do { _Pragma("unroll") for (int m = 0; m < 4; ++m) _Pragma("unroll") for (int k = 0; k < 2; ++k) dst[m][k] = *(const PG8_LAS bf16x8*)(lds + PG8_SA(b, h) + aoff + m * 2048 + k * 1024); } while (0)
#define PG8_LDB(dst, b, h) do { _Pragma("unroll") for (int n = 0; n < 2; ++n) _Pragma("unroll") for (int k = 0; k < 2; ++k) dst[n][k] = *(const PG8_LAS bf16x8*)(lds + PG8_SB(b, h) + boff + n * 2048 + k * 1024); } while (0)
#define PG8_MMA(ai, bj, At, Bt) do { __builtin_amdgcn_s_setprio(1); _Pragma("unroll") for (int m = 0; m < 4; ++m) _Pragma("unroll") for (int n = 0; n < 2; ++n) _Pragma("unroll") for (int k = 0; k < 2; ++k) \
        acc[ai][bj][m][n] = __builtin_amdgcn_mfma_f32_16x16x32_bf16(Bt[n][k], At[m][k], acc[ai][bj][m][n], 0, 0, 0); __builtin_amdgcn_s_setprio(0); } while (0)
#define PG8_WAIT_V(n) asm volatile("s_waitcnt vmcnt(" #n ")" ::: "memory")
#define PG8_WAIT_L(n) asm volatile("s_waitcnt lgkmcnt(" #n ")" ::: "memory")
#define PG8_BAR __builtin_amdgcn_s_barrier()
#define PG8_SCHED __builtin_amdgcn_sched_barrier(0)
    Unit cur, nxt; int ui = 0;
    if (!S.next(0, cur)) return;
    f32x4 acc[2][2][4][2];
#pragma unroll
    for (int a = 0; a < 2; ++a)
#pragma unroll
        for (int b = 0; b < 2; ++b)
#pragma unroll
            for (int m = 0; m < 4; ++m)
#pragma unroll
                for (int n = 0; n < 2; ++n) acc[a][b][m][n] = (f32x4){0.f, 0.f, 0.f, 0.f};
    bf16x8 At[4][2], B0[2][2], B1[2][2];
    const char* cA = (const char*)g.A + (size_t)cur.pm * tstepA; const char* cB = (const char*)g.Bt + (size_t)cur.pn * tstep;
    S.a_ready(cur);
    PG8_STAGE(PG8_SB(0, 0), cB, voffB); PG8_STAGE(PG8_SA(0, 0), cA, voffA); PG8_STAGE(PG8_SB(0, 1), cB + hstep, voffB); PG8_STAGE(PG8_SA(0, 1), cA + hstepA, voffA);
    if (wr == 1) PG8_BAR;
    PG8_WAIT_V(4); PG8_BAR;
    PG8_STAGE(PG8_SB(1, 0), cB + kstep, voffB); PG8_STAGE(PG8_SA(1, 0), cA + kstep, voffA); PG8_STAGE(PG8_SB(1, 1), cB + hstep + kstep, voffB);
    PG8_WAIT_V(6); PG8_BAR;
    for (;;) {
        const bool has_next = S.next(ui + 1, nxt);
        const char* nA = has_next ? (const char*)g.A + (size_t)nxt.pm * tstepA : cA; const char* nB = has_next ? (const char*)g.Bt + (size_t)nxt.pn * tstep : cB;
        for (int t = 0; t < nt; t += 2) {
            const bool last = (t == nt - 2);
            const char* a1 = cA + (size_t)(t + 1) * kstep;
            const char* a2 = last ? nA : cA + (size_t)(t + 2) * kstep; const char* b2 = last ? nB : cB + (size_t)(t + 2) * kstep;
            const char* a3 = a2 + kstep; const char* b3 = b2 + kstep;
            if (last && has_next) S.a_ready(nxt);
            PG8_LDB(B0, 0, 0); PG8_SCHED; PG8_LDA(At, 0, 0); PG8_STAGE(PG8_SA(1, 1), a1 + hstepA, voffA);
            PG8_WAIT_L(8); PG8_BAR; PG8_WAIT_L(0); PG8_MMA(0, 0, At, B0); PG8_BAR; PG8_SCHED;
            PG8_LDB(B1, 0, 1); PG8_STAGE(PG8_SB(0, 0), b2, voffB);
            PG8_BAR; PG8_WAIT_L(0); PG8_MMA(0, 1, At, B1); PG8_BAR;
            PG8_LDA(At, 0, 1); PG8_STAGE(PG8_SA(0, 0), a2, voffA);
            PG8_BAR; PG8_WAIT_L(0); PG8_MMA(1, 0, At, B0); PG8_BAR; PG8_SCHED;
            PG8_STAGE(PG8_SB(0, 1), b2 + hstep, voffB);
            PG8_WAIT_V(6); PG8_BAR; PG8_MMA(1, 1, At, B1); PG8_BAR;
            PG8_LDB(B0, 1, 0); PG8_SCHED; PG8_LDA(At, 1, 0); PG8_STAGE(PG8_SA(0, 1), a2 + hstepA, voffA);
            PG8_WAIT_L(8); PG8_BAR; PG8_WAIT_L(0); PG8_MMA(0, 0, At, B0); PG8_BAR; PG8_SCHED;
            PG8_LDB(B1, 1, 1); PG8_STAGE(PG8_SB(1, 0), b3, voffB);
            PG8_BAR; PG8_WAIT_L(0); PG8_MMA(0, 1, At, B1); PG8_BAR;
            PG8_LDA(At, 1, 1); PG8_STAGE(PG8_SA(1, 0), a3, voffA);
            PG8_BAR; PG8_WAIT_L(0); PG8_MMA(1, 0, At, B0); PG8_BAR; PG8_SCHED;
            PG8_STAGE(PG8_SB(1, 1), b3 + hstep, voffB);
            PG8_WAIT_V(6); PG8_BAR; PG8_MMA(1, 1, At, B1); PG8_BAR;
        }
        if constexpr (!Epi::AFTER_DRAIN) { E(acc, cur, wr, wc, fr, fq); S.done(cur); }
        if (!has_next) break;
#pragma unroll
        for (int a = 0; a < 2; ++a)
#pragma unroll
            for (int b = 0; b < 2; ++b)
#pragma unroll
                for (int m = 0; m < 4; ++m)
#pragma unroll
                    for (int n = 0; n < 2; ++n) acc[a][b][m][n] = (f32x4){0.f, 0.f, 0.f, 0.f};
        cur = nxt; cA = nA; cB = nB; ++ui;
    }
    PG8_WAIT_V(0);
    if (wr == 0) PG8_BAR;
    PG8_BAR;
    if constexpr (Epi::AFTER_DRAIN) { E.fused(acc, cur, wr, wc, fr, fq, lds, wid, lane); S.done(cur); }
#undef PG8_SA
#undef PG8_SB
#undef PG8_STAGE
#undef PG8_LDA
#undef PG8_LDB
#undef PG8_MMA
#undef PG8_WAIT_V
#undef PG8_WAIT_L
#undef PG8_BAR
#undef PG8_SCHED
}
}

using pg8::bf16_t; using pg8::bf16x8; using pg8::f32x4; using pg8::u32x4; using pg8::cvt_pk_bf16;
#define LAS __attribute__((address_space(3)))
typedef unsigned short u16x4 __attribute__((ext_vector_type(4)));
typedef unsigned u32x2 __attribute__((ext_vector_type(2)));

constexpr int T_TOK = 32768, SEQ = 4096, DM = 1024, DFF = 2816;
constexpr int IN_LD = 5632;
constexpr int C_Q = 0, C_K = 512, C_V = 1024, C_R = 2048, C_Z = 3072, C_X = 4096, C_B = 5120, C_C = 5376;
constexpr size_t MiB = 1024 * 1024;
constexpr size_t WS_IN = 0;
constexpr size_t WS_ACT = 0;
constexpr size_t WS_Q = 0;
constexpr size_t WS_QIDX = 128 * MiB;
constexpr size_t WS_RAW1 = 192 * MiB;
constexpr size_t WS_OLAT = 192 * MiB;
constexpr size_t WS_QLAT = 320 * MiB;
constexpr size_t WS_KV = 336 * MiB;
constexpr size_t WS_KIDX = 344 * MiB;
constexpr size_t WS_WIDX = 348 * MiB;
constexpr size_t WS_XB = 352 * MiB;
constexpr size_t WS_SS = 416 * MiB;
constexpr size_t WS_SMALL = 418 * MiB;
constexpr size_t WS_W = 422 * MiB;
constexpr size_t W_GU = WS_W;
constexpr size_t W_GU_SZ = (size_t)5632 * 1024 * 2;
constexpr size_t W_D = W_GU + 4 * W_GU_SZ;
constexpr size_t W_D_SZ = (size_t)1024 * 2816 * 2;
constexpr size_t W_IN = W_D + 4 * W_D_SZ;
constexpr size_t W_OUT = W_IN + (size_t)5888 * 1024 * 2;
constexpr size_t W_D1 = W_OUT + (size_t)1024 * 2048 * 2;
constexpr size_t W_D3 = W_D1 + (size_t)512 * 1024 * 2;
constexpr size_t W_C = W_D3 + (size_t)3072 * 256 * 2;
constexpr size_t WS_END = W_C + (size_t)1024 * 2048 * 2;
constexpr size_t WS_BAR = 511 * MiB;
static_assert(WS_END <= WS_BAR, "workspace");
constexpr int LDS_BYTES = 163840;

struct Params { const float* in[31]; float* out; unsigned char* ws; int ph_lo, ph_hi, flags, pad; };

typedef const __attribute__((address_space(4))) char* kptr_t;
__device__ __forceinline__ kptr_t kargs() { kptr_t ka = (kptr_t)__builtin_amdgcn_kernarg_segment_ptr(); asm volatile("" : "+s"(ka)); return ka; }
#define PIN(i) (*(const float* const __attribute__((address_space(4)))*)(kargs() + 8 * (i)))
#define POUT (*(float* const __attribute__((address_space(4)))*)(kargs() + 248))
#define PWS (*(unsigned char* const __attribute__((address_space(4)))*)(kargs() + 256))
#define PARG_I(off) (*(const int __attribute__((address_space(4)))*)(kargs() + (off)))
__device__ __forceinline__ float bf2f(bf16_t v) { return __uint_as_float(((unsigned)v) << 16); }
__device__ __forceinline__ bf16_t f2bf(float f) { return __builtin_bit_cast(bf16_t, (__bf16)f); }
__device__ __forceinline__ float wave_sum(float v) {
#define WS_DPP(x, ctrl) __builtin_bit_cast(float, __builtin_amdgcn_update_dpp(0, __builtin_bit_cast(int, (x)), (ctrl), 0xF, 0xF, true))
    v += WS_DPP(v, 0xB1); v += WS_DPP(v, 0x4E); v += WS_DPP(v, 0x141); v += WS_DPP(v, 0x140);
#undef WS_DPP
    { const unsigned u = __float_as_uint(v); const auto r = __builtin_amdgcn_permlane16_swap(u, u, false, false); v = __uint_as_float(r[0]) + __uint_as_float(r[1]); }
    { const unsigned u = __float_as_uint(v); const auto r = __builtin_amdgcn_permlane32_swap(u, u, false, false); v = __uint_as_float(r[0]) + __uint_as_float(r[1]); }
    return v; }
__device__ __forceinline__ float silu_f(float x) { return x * __builtin_amdgcn_rcpf(1.0f + __builtin_amdgcn_exp2f(x * -1.4426950408889634f)); }
__device__ __forceinline__ float row_rstd(const float* ss, int row) {
    const f32x4* p = (const f32x4*)(ss + (size_t)row * 16); const f32x4 a = p[0], b = p[1], c = p[2], d = p[3];
    const float s = (((a[0] + a[1]) + (a[2] + a[3])) + ((b[0] + b[1]) + (b[2] + b[3]))) + (((c[0] + c[1]) + (c[2] + c[3])) + ((d[0] + d[1]) + (d[2] + d[3])));
    return rsqrtf(s * (1.0f / 1024.0f) + 1e-6f);
}

__device__ __forceinline__ void rows_rstd(const float* ss, int row0, float (&rs)[8]) {
#pragma unroll
    for (int hf = 0; hf < 2; ++hf) {
        f32x4 t[4][4];
#pragma unroll
        for (int i = 0; i < 4; ++i) { const f32x4* p = (const f32x4*)(ss + (size_t)(row0 + hf * 128 + i * 16) * 16);
#pragma unroll
            for (int q = 0; q < 4; ++q) t[i][q] = p[q]; }
#pragma unroll
        for (int i = 0; i < 4; ++i) { const f32x4 a = t[i][0] + t[i][1], b = t[i][2] + t[i][3]; const f32x4 c = a + b; rs[hf * 4 + i] = rsqrtf(((c[0] + c[1]) + (c[2] + c[3])) * (1.0f / 1024.0f) + 1e-6f); }
        asm volatile("" ::: "memory");
    }
}
constexpr int RSTD_TAB = 131072 + 8192;
__device__ __forceinline__ void rows_rstd_cached(const float* ss, int pm, int wr, int wc, int fr, int& cpm, float (&rs)[8]) {
    LAS float* tab = (LAS float*)((LAS unsigned char*)0 + RSTD_TAB) + (wr * 4 + wc) * 128;
    if (pm != cpm) { cpm = pm; const int lane = threadIdx.x & 63;
        f32x4 t[2][4];
#pragma unroll
        for (int h = 0; h < 2; ++h) { const f32x4* p = (const f32x4*)(ss + (size_t)(pm * 256 + h * 128 + wr * 64 + lane) * 16);
#pragma unroll
            for (int q = 0; q < 4; ++q) t[h][q] = p[q]; }
#pragma unroll
        for (int h = 0; h < 2; ++h) { const f32x4 a = t[h][0] + t[h][1], b = t[h][2] + t[h][3]; const f32x4 c = a + b; tab[h * 64 + lane] = rsqrtf(((c[0] + c[1]) + (c[2] + c[3])) * (1.0f / 1024.0f) + 1e-6f); }
        asm volatile("s_waitcnt lgkmcnt(0)" ::: "memory"); }
#pragma unroll
    for (int i = 0; i < 8; ++i) rs[i] = tab[(i >> 2) * 64 + (i & 3) * 16 + fr];
}
struct EpiGU {
    static constexpr bool PERM = true, AFTER_DRAIN = false;
    bf16_t* act; const float* ss; mutable int cpm;
    __device__ __forceinline__ void operator()(const f32x4 (&acc)[2][2][4][2], const pg8::Unit& u, int wr, int wc, int fr, int fq) const {
        const int row0 = u.pm * 256 + wr * 64 + fr, col0 = u.pn * 128 + wc * 32 + 8 * fq;
        float rsv[8]; rows_rstd_cached(ss, u.pm, wr, wc, fr, cpm, rsv);
#pragma unroll
        for (int ai = 0; ai < 2; ++ai)
#pragma unroll
            for (int m = 0; m < 4; ++m) { const int r = row0 + ai * 128 + m * 16; const float rs = rsv[ai * 4 + m];
                const float ea = rs * -1.4426950408889634f, r2 = rs * rs;
                float o[8];
#pragma unroll
                for (int n = 0; n < 2; ++n) { const f32x4 gv = acc[ai][0][m][n], uv = acc[ai][1][m][n]; const f32x4 xa = gv * ea, pu = (gv * uv) * r2; f32x4 rc;
#pragma unroll
                    for (int e = 0; e < 4; ++e) rc[e] = __builtin_amdgcn_rcpf(1.0f + __builtin_amdgcn_exp2f(xa[e]));
                    const f32x4 ov = pu * rc;
#pragma unroll
                    for (int e = 0; e < 4; ++e) o[n * 4 + e] = ov[e]; }
                u32x4 w; w.x = cvt_pk_bf16(o[0], o[1]); w.y = cvt_pk_bf16(o[2], o[3]); w.z = cvt_pk_bf16(o[4], o[5]); w.w = cvt_pk_bf16(o[6], o[7]);
                *(u32x4*)(act + (size_t)r * DFF + col0) = w; }
    }
};
struct EpiRes {
    static constexpr bool PERM = true, AFTER_DRAIN = false;
    const float* res32; bf16_t* XB; float* ss;
    __device__ __forceinline__ void operator()(const f32x4 (&acc)[2][2][4][2], const pg8::Unit& u, int wr, int wc, int fr, int fq) const {
        const int row0 = u.pm * 256 + wr * 64 + fr, col0 = u.pn * 256 + wc * 32 + 8 * fq;
        if (res32) {
#pragma unroll
            for (int ai = 0; ai < 2; ++ai) {
                f32x4 rv[4][2][2];
#pragma unroll
                for (int m = 0; m < 4; ++m)
#pragma unroll
                    for (int bj = 0; bj < 2; ++bj)
#pragma unroll
                        for (int n = 0; n < 2; ++n) rv[m][bj][n] = *(const f32x4*)(res32 + (size_t)(row0 + ai * 128 + m * 16) * DM + col0 + bj * 128 + n * 4);
                asm volatile("" ::: "memory");
#pragma unroll
                for (int m = 0; m < 4; ++m) { const int r = row0 + ai * 128 + m * 16; float sq = 0.f;
#pragma unroll
                    for (int bj = 0; bj < 2; ++bj) { const f32x4 v0 = rv[m][bj][0] + acc[ai][bj][m][0], v1 = rv[m][bj][1] + acc[ai][bj][m][1];
                        sq += ((v0[0] * v0[0] + v0[1] * v0[1]) + (v0[2] * v0[2] + v0[3] * v0[3])) + ((v1[0] * v1[0] + v1[1] * v1[1]) + (v1[2] * v1[2] + v1[3] * v1[3]));
                        u32x4 w; w.x = cvt_pk_bf16(v0[0], v0[1]); w.y = cvt_pk_bf16(v0[2], v0[3]); w.z = cvt_pk_bf16(v1[0], v1[1]); w.w = cvt_pk_bf16(v1[2], v1[3]);
                        *(u32x4*)(XB + (size_t)r * DM + col0 + bj * 128) = w; }
                    sq += __shfl_xor(sq, 16); sq += __shfl_xor(sq, 32);
                    if (fq == 0) ss[(size_t)r * 16 + u.pn * 4 + wc] = sq; }
            }
        } else {
            u32x4 rb[2][4][2];
#pragma unroll
            for (int ai = 0; ai < 2; ++ai)
#pragma unroll
                for (int m = 0; m < 4; ++m)
#pragma unroll
                    for (int bj = 0; bj < 2; ++bj) rb[ai][m][bj] = *(const u32x4*)(XB + (size_t)(row0 + ai * 128 + m * 16) * DM + col0 + bj * 128);
            asm volatile("" ::: "memory");
#pragma unroll
            for (int ai = 0; ai < 2; ++ai)
#pragma unroll
                for (int m = 0; m < 4; ++m) { const int r = row0 + ai * 128 + m * 16; float sq = 0.f;
#pragma unroll
                    for (int bj = 0; bj < 2; ++bj) { const u32x4 q = rb[ai][m][bj];
                        f32x4 v0, v1; v0[0] = __uint_as_float(q.x << 16); v0[1] = __uint_as_float(q.x & 0xffff0000u); v0[2] = __uint_as_float(q.y << 16); v0[3] = __uint_as_float(q.y & 0xffff0000u);
                        v1[0] = __uint_as_float(q.z << 16); v1[1] = __uint_as_float(q.z & 0xffff0000u); v1[2] = __uint_as_float(q.w << 16); v1[3] = __uint_as_float(q.w & 0xffff0000u);
                        v0 = v0 + acc[ai][bj][m][0]; v1 = v1 + acc[ai][bj][m][1];
                        sq += ((v0[0] * v0[0] + v0[1] * v0[1]) + (v0[2] * v0[2] + v0[3] * v0[3])) + ((v1[0] * v1[0] + v1[1] * v1[1]) + (v1[2] * v1[2] + v1[3] * v1[3]));
                        u32x4 w; w.x = cvt_pk_bf16(v0[0], v0[1]); w.y = cvt_pk_bf16(v0[2], v0[3]); w.z = cvt_pk_bf16(v1[0], v1[1]); w.w = cvt_pk_bf16(v1[2], v1[3]);
                        *(u32x4*)(XB + (size_t)r * DM + col0 + bj * 128) = w; }
                    sq += __shfl_xor(sq, 16); sq += __shfl_xor(sq, 32);
                    if (fq == 0) ss[(size_t)r * 16 + u.pn * 4 + wc] = sq; }
        }
    }
};
struct EpiIn {
    static constexpr bool PERM = true, AFTER_DRAIN = false;
    bf16_t* IN; float* small; const float* ss; mutable int cpm;
    __device__ __forceinline__ void operator()(const f32x4 (&acc)[2][2][4][2], const pg8::Unit& u, int wr, int wc, int fr, int fq) const {
        const int row0 = u.pm * 256 + wr * 64 + fr, col0 = u.pn * 256 + wc * 32 + 8 * fq;
        float rsv[8]; rows_rstd_cached(ss, u.pm, wr, wc, fr, cpm, rsv);
        if (u.pn < 22) {
#pragma unroll
            for (int ai = 0; ai < 2; ++ai)
#pragma unroll
                for (int m = 0; m < 4; ++m) { const int r = row0 + ai * 128 + m * 16; const float rs = rsv[ai * 4 + m];
#pragma unroll
                    for (int bj = 0; bj < 2; ++bj) { const f32x4 v0 = acc[ai][bj][m][0] * rs, v1 = acc[ai][bj][m][1] * rs;
                        u32x4 w; w.x = cvt_pk_bf16(v0[0], v0[1]); w.y = cvt_pk_bf16(v0[2], v0[3]); w.z = cvt_pk_bf16(v1[0], v1[1]); w.w = cvt_pk_bf16(v1[2], v1[3]);
                        *(u32x4*)(IN + (size_t)r * IN_LD + col0 + bj * 128) = w; } }
        } else if (wc == 0) {
#pragma unroll
            for (int ai = 0; ai < 2; ++ai)
#pragma unroll
                for (int m = 0; m < 4; ++m) { const int r = row0 + ai * 128 + m * 16; const float rs = rsv[ai * 4 + m];
                    *(f32x4*)(small + (size_t)r * 32 + 8 * fq) = acc[ai][0][m][0] * rs; *(f32x4*)(small + (size_t)r * 32 + 8 * fq + 4) = acc[ai][0][m][1] * rs; }
        }
    }
};
struct EpiD1 {
    static constexpr bool PERM = false, AFTER_DRAIN = false;
    float* raw; const float* ss; mutable int cpm;
    __device__ __forceinline__ void operator()(const f32x4 (&acc)[2][2][4][2], const pg8::Unit& u, int wr, int wc, int fr, int fq) const {
        const int row0 = u.pm * 256 + wr * 64 + fr, col0 = u.pn * 256 + wc * 32 + 4 * fq;
        float rsv[8]; rows_rstd_cached(ss, u.pm, wr, wc, fr, cpm, rsv);
#pragma unroll
        for (int ai = 0; ai < 2; ++ai)
#pragma unroll
            for (int m = 0; m < 4; ++m) { const int r = row0 + ai * 128 + m * 16; const float rs = rsv[ai * 4 + m];
#pragma unroll
                for (int bj = 0; bj < 2; ++bj)
#pragma unroll
                    for (int n = 0; n < 2; ++n) *(f32x4*)(raw + (size_t)r * 512 + col0 + bj * 128 + n * 16) = acc[ai][bj][m][n] * rs; }
    }
};
struct EpiD1F {
    static constexpr bool PERM = false, AFTER_DRAIN = true;
    const float* ss; bf16_t* QL; bf16_t* KV; bf16_t* KI; float* WI; const float* qg; const float* kg; const float* lg; const float* lb; mutable int cpm;
    __device__ __forceinline__ void fused(f32x4 (&acc)[2][2][4][2], const pg8::Unit& u, int wr, int wc, int fr, int fq, LAS unsigned char* lds, int wid, int lane) const {
        (void)wid; (void)lane;
        float rsv[8]; rows_rstd_cached(ss, u.pm, wr, wc, fr, cpm, rsv);
#pragma unroll
        for (int ai = 0; ai < 2; ++ai)
#pragma unroll
            for (int m = 0; m < 4; ++m)
#pragma unroll
                for (int bj = 0; bj < 2; ++bj)
#pragma unroll
                    for (int n = 0; n < 2; ++n) acc[ai][bj][m][n] = acc[ai][bj][m][n] * rsv[ai * 4 + m];
        LAS f32x4* P = (LAS f32x4*)lds;
        const int rl0 = wr * 64 + fr;
        if (u.pn == 0) {
#pragma unroll
            for (int ai = 0; ai < 2; ++ai)
#pragma unroll
                for (int m = 0; m < 4; ++m) { float sq = 0.f;
#pragma unroll
                    for (int bj = 0; bj < 2; ++bj)
#pragma unroll
                        for (int n = 0; n < 2; ++n) { const f32x4 v = acc[ai][bj][m][n]; sq += (v[0] * v[0] + v[1] * v[1]) + (v[2] * v[2] + v[3] * v[3]); }
                    sq += __shfl_xor(sq, 16); sq += __shfl_xor(sq, 32);
                    if (fq == 0) P[(ai * 128 + rl0 + m * 16) * 4 + wc] = (f32x4){sq, 0.f, 0.f, 0.f}; }
            __syncthreads();
#pragma unroll
            for (int ai = 0; ai < 2; ++ai)
#pragma unroll
                for (int m = 0; m < 4; ++m) { const int rl = ai * 128 + rl0 + m * 16; const size_t row = (size_t)u.pm * 256 + rl;
                    const float tot = (P[rl * 4 + 0][0] + P[rl * 4 + 1][0]) + (P[rl * 4 + 2][0] + P[rl * 4 + 3][0]); const float rq = rsqrtf(tot * (1.0f / 256.0f) + 1e-6f);
#pragma unroll
                    for (int bj = 0; bj < 2; ++bj)
#pragma unroll
                        for (int n = 0; n < 2; ++n) { const int c = bj * 128 + wc * 32 + n * 16 + 4 * fq; const f32x4 g = *(const f32x4*)(qg + c); const f32x4 v = acc[ai][bj][m][n] * rq * g;
                            u32x2 w; w.x = cvt_pk_bf16(v[0], v[1]); w.y = cvt_pk_bf16(v[2], v[3]); *(u32x2*)(QL + row * 256 + c) = w; } }
        } else {
#pragma unroll
            for (int ai = 0; ai < 2; ++ai)
#pragma unroll
                for (int m = 0; m < 4; ++m) { float skv = 0.f, s1 = 0.f, s2 = 0.f;
#pragma unroll
                    for (int n = 0; n < 2; ++n) { const f32x4 v = acc[ai][0][m][n]; skv += (v[0] * v[0] + v[1] * v[1]) + (v[2] * v[2] + v[3] * v[3]);
                        const f32x4 k = acc[ai][1][m][n]; s1 += (k[0] + k[1]) + (k[2] + k[3]); s2 += (k[0] * k[0] + k[1] * k[1]) + (k[2] * k[2] + k[3] * k[3]); }
                    if (wc >= 2) { s1 = 0.f; s2 = 0.f; }
                    skv += __shfl_xor(skv, 16); skv += __shfl_xor(skv, 32); s1 += __shfl_xor(s1, 16); s1 += __shfl_xor(s1, 32); s2 += __shfl_xor(s2, 16); s2 += __shfl_xor(s2, 32);
                    if (fq == 0) P[(ai * 128 + rl0 + m * 16) * 4 + wc] = (f32x4){skv, s1, s2, 0.f}; }
            __syncthreads();
#pragma unroll
            for (int ai = 0; ai < 2; ++ai)
#pragma unroll
                for (int m = 0; m < 4; ++m) { const int rl = ai * 128 + rl0 + m * 16; const size_t row = (size_t)u.pm * 256 + rl;
                    const f32x4 p0 = P[rl * 4 + 0], p1 = P[rl * 4 + 1], p2 = P[rl * 4 + 2], p3 = P[rl * 4 + 3];
                    const float rkv = rsqrtf(((p0[0] + p1[0]) + (p2[0] + p3[0])) * (1.0f / 128.0f) + 1e-6f);
                    const float mu = (p0[1] + p1[1]) * (1.0f / 64.0f); const float var = fmaxf((p0[2] + p1[2]) * (1.0f / 64.0f) - mu * mu, 0.f); const float rki = rsqrtf(var + 1e-6f);
#pragma unroll
                    for (int n = 0; n < 2; ++n) { const int c = wc * 32 + n * 16 + 4 * fq;
                        { const f32x4 g = *(const f32x4*)(kg + c); const f32x4 v = acc[ai][0][m][n] * rkv * g; u32x2 w; w.x = cvt_pk_bf16(v[0], v[1]); w.y = cvt_pk_bf16(v[2], v[3]); *(u32x2*)(KV + row * 128 + c) = w; }
                        if (wc < 2) { const f32x4 g = *(const f32x4*)(lg + c), bb = *(const f32x4*)(lb + c); const f32x4 v = (acc[ai][1][m][n] - mu) * rki * g + bb;
                            u32x2 w; w.x = cvt_pk_bf16(v[0], v[1]); w.y = cvt_pk_bf16(v[2], v[3]); *(u32x2*)(KI + row * 64 + c) = w; }
                        else if (wc == 2 && n == 0) *(f32x4*)(WI + row * 16 + 4 * fq) = acc[ai][1][m][0] * 0.03125f; } }
        }
        __syncthreads();
    }
};
struct EpiD3 {
    static constexpr bool PERM = true, AFTER_DRAIN = false;
    bf16_t* Q; bf16_t* QI;
    __device__ __forceinline__ void operator()(const f32x4 (&acc)[2][2][4][2], const pg8::Unit& u, int wr, int wc, int fr, int fq) const {
        const int row0 = u.pm * 256 + wr * 64 + fr; const bool isq = u.pn < 8;
        bf16_t* base = isq ? Q : QI; const int ld = isq ? 2048 : 1024; const int col0 = (isq ? u.pn : u.pn - 8) * 256 + wc * 32 + 8 * fq;
#pragma unroll
        for (int ai = 0; ai < 2; ++ai)
#pragma unroll
            for (int m = 0; m < 4; ++m) { const int r = row0 + ai * 128 + m * 16;
#pragma unroll
                for (int bj = 0; bj < 2; ++bj) { const f32x4 v0 = acc[ai][bj][m][0], v1 = acc[ai][bj][m][1];
                    u32x4 w; w.x = cvt_pk_bf16(v0[0], v0[1]); w.y = cvt_pk_bf16(v0[2], v0[3]); w.z = cvt_pk_bf16(v1[0], v1[1]); w.w = cvt_pk_bf16(v1[2], v1[3]);
                    *(u32x4*)(base + (size_t)r * ld + col0 + bj * 128) = w; } }
    }
};
template <class Epi> __device__ __forceinline__ void run_gemm(LAS unsigned char* lds, const bf16_t* A, int lda, const bf16_t* Bt, int M, int N, int K, const Epi& E, int wgm = 8) {
    pg8::Gemm g; g.A = A; g.Bt = Bt; g.M = M; g.N = N; g.K = K; g.lda = lda;
    pg8::StaticOrder S; S.init(M, N, (int)gridDim.x, (int)blockIdx.x, wgm);
    pg8::gemm_phase<Epi, pg8::StaticOrder>(lds, g, S, E);
}

struct PrepJob { const float* src; int src_ld, col0, ncols, K; bf16_t* dst; int grp, grp_stride, grp_off; const float* gain; float scale; };
__device__ __forceinline__ PrepJob mkjob(const float* src, int src_ld, int col0, int ncols, int K, bf16_t* dst, int grp, int gs, int go, const float* gain, float scale) {
    PrepJob j; j.src = src; j.src_ld = src_ld; j.col0 = col0; j.ncols = ncols; j.K = K; j.dst = dst; j.grp = grp; j.grp_stride = gs; j.grp_off = go; j.gain = gain; j.scale = scale; return j; }
__device__ __forceinline__ PrepJob get_job(int j) {
    const int BIG = 1 << 30; unsigned char* ws = PWS;
    if (j < 12) { const int lf = j / 3, k = j % 3;
        if (k == 0) return mkjob(PIN(2) + (size_t)lf * 1024 * 2816, 2816, 0, 2816, 1024, (bf16_t*)(ws + W_GU + lf * W_GU_SZ), 128, 256, 0, PIN(1) + lf * 1024, 1.0f);
        if (k == 1) return mkjob(PIN(3) + (size_t)lf * 1024 * 2816, 2816, 0, 2816, 1024, (bf16_t*)(ws + W_GU + lf * W_GU_SZ), 128, 256, 128, PIN(1) + lf * 1024, 1.0f);
        return mkjob(PIN(4) + (size_t)lf * 2816 * 1024, 1024, 0, 1024, 2816, (bf16_t*)(ws + W_D + lf * W_D_SZ), BIG, 0, 0, nullptr, 0.5f); }
    j -= 12;
    if (j < 8) { bf16_t* d = (bf16_t*)(ws + W_IN); const float* s = PIN(6); const float* gn = PIN(5);
        switch (j) {
            case 0: return mkjob(s, 5664, 0, 512, 1024, d, BIG, 0, 0, gn, 0.08838834764831845f);
            case 1: return mkjob(s, 5664, 512, 512, 1024, d, BIG, 0, 512, gn, 1.0f);
            case 2: return mkjob(s, 5664, 1024, 1024, 1024, d, BIG, 0, 1024, gn, 1.0f);
            case 3: return mkjob(s, 5664, 2048, 1024, 1024, d, BIG, 0, 2048, gn, 1.0f);
            case 4: return mkjob(s, 5664, 3072, 16, 1024, d, BIG, 0, 5632, gn, 1.0f);
            case 5: return mkjob(s, 5664, 3088, 1024, 1024, d, BIG, 0, 3072, gn, 1.0f);
            case 6: return mkjob(s, 5664, 4112, 1536, 1024, d, BIG, 0, 4096, gn, 1.0f);
            default: return mkjob(s, 5664, 5648, 16, 1024, d, BIG, 0, 5648, gn, 1.0f);
        } }
    j -= 8;
    if (j == 0) return mkjob(PIN(16), 1024, 0, 1024, 2048, (bf16_t*)(ws + W_OUT), BIG, 0, 0, nullptr, 1.0f);
    j -= 1;
    if (j < 4) { bf16_t* d = (bf16_t*)(ws + W_D1); const float* gn = PIN(5) + 1024;
        switch (j) {
            case 0: return mkjob(PIN(17), 256, 0, 256, 1024, d, BIG, 0, 0, gn, 1.0f);
            case 1: return mkjob(PIN(20), 128, 0, 128, 1024, d, BIG, 0, 256, gn, 1.0f);
            case 2: return mkjob(PIN(25), 64, 0, 64, 1024, d, BIG, 0, 384, gn, 1.0f);
            default: return mkjob(PIN(28), 16, 0, 16, 1024, d, BIG, 0, 448, gn, 1.0f);
        } }
    j -= 4;
    if (j == 0) return mkjob(PIN(19), 2048, 0, 2048, 256, (bf16_t*)(ws + W_D3), BIG, 0, 0, nullptr, 0.08838834764831845f);
    return mkjob(PIN(24), 1024, 0, 1024, 256, (bf16_t*)(ws + W_D3), BIG, 0, 2048, nullptr, 1.0f);
}
constexpr int N_PREP_JOBS = 27;

__device__ __forceinline__ void phase_prologue(LAS unsigned char* lds) {
    const int tid = threadIdx.x, wid = tid >> 6, lane = tid & 63;
    { const float* x = PIN(0); bf16_t* XB = (bf16_t*)(PWS + WS_XB); float* ss = (float*)(PWS + WS_SS);
      for (int row = blockIdx.x * 8 + wid; row < T_TOK; row += gridDim.x * 8) {
          float sq = 0.f;
#pragma unroll
          for (int i = 0; i < 4; ++i) { const size_t o = (size_t)row * DM + i * 256 + lane * 4; const f32x4 v = *(const f32x4*)(x + o);
              sq += (v[0] * v[0] + v[1] * v[1]) + (v[2] * v[2] + v[3] * v[3]); u32x2 w; w.x = cvt_pk_bf16(v[0], v[1]); w.y = cvt_pk_bf16(v[2], v[3]); *(u32x2*)(XB + o) = w; }
          sq = wave_sum(sq);
          if (lane < 16) ss[(size_t)row * 16 + lane] = lane == 0 ? sq : 0.f; } }
    LAS bf16_t* Tl = (LAS bf16_t*)lds;
    for (int j = 0; j < N_PREP_JOBS; ++j) { const PrepJob J = get_job(j); const int nct = (J.ncols + 63) / 64, nt = (J.K / 64) * nct;
        for (int tile = blockIdx.x; tile < nt; tile += gridDim.x) { const int k0 = (tile / nct) * 64, n0 = (tile % nct) * 64;
#pragma unroll
            for (int i = 0; i < 2; ++i) { const int kl = (tid >> 4) + 32 * i, nl = (tid & 15) * 4;
                if (n0 + nl < J.ncols) { const f32x4 v = *(const f32x4*)(J.src + (size_t)(k0 + kl) * J.src_ld + J.col0 + n0 + nl); const float s = J.scale * (J.gain ? J.gain[k0 + kl] : 1.0f);
                    Tl[(nl + 0) * 72 + kl] = f2bf(v[0] * s); Tl[(nl + 1) * 72 + kl] = f2bf(v[1] * s); Tl[(nl + 2) * 72 + kl] = f2bf(v[2] * s); Tl[(nl + 3) * 72 + kl] = f2bf(v[3] * s); } }
            __syncthreads();
            { const int n = tid >> 3, k8 = (tid & 7) * 8;
              if (n0 + n < J.ncols) { const int jj = n0 + n, dr = (jj / J.grp) * J.grp_stride + J.grp_off + (jj % J.grp);
                  *(u32x4*)(J.dst + (size_t)dr * J.K + k0 + k8) = *(const LAS u32x4*)(Tl + n * 72 + k8); } }
            __syncthreads(); } }
    { u32x4 z = {0u, 0u, 0u, 0u}; u32x4* a = (u32x4*)(PWS + W_IN + (size_t)5664 * 1024 * 2); const int na = 224 * 1024 * 2 / 16;
      for (int i = blockIdx.x * 512 + tid; i < na; i += gridDim.x * 512) a[i] = z;
      u32x4* b = (u32x4*)(PWS + W_D1 + (size_t)464 * 1024 * 2); const int nb = 48 * 1024 * 2 / 16;
      for (int i = blockIdx.x * 512 + tid; i < nb; i += gridDim.x * 512) b[i] = z; }
    { const float* wuv = PIN(22); const float* wo = PIN(23); bf16_t* WC = (bf16_t*)(PWS + W_C);
      for (int it = blockIdx.x * 512 + tid; it < 1024 * 256; it += gridDim.x * 512) { const int d = it & 1023, cb = it >> 10, h = cb >> 4, c0 = (cb & 15) * 8;
          float a[8] = {0.f, 0.f, 0.f, 0.f, 0.f, 0.f, 0.f, 0.f};
          for (int e = 0; e < 64; ++e) { const float w = wo[(size_t)(h * 64 + e) * 1024 + d];
#pragma unroll
              for (int i = 0; i < 8; ++i) a[i] += wuv[((size_t)h * 128 + c0 + i) * 64 + e] * w; }
          u32x4 o; o.x = cvt_pk_bf16(a[0], a[1]); o.y = cvt_pk_bf16(a[2], a[3]); o.z = cvt_pk_bf16(a[4], a[5]); o.w = cvt_pk_bf16(a[6], a[7]);
          *(u32x4*)(WC + (size_t)d * 2048 + h * 128 + c0) = o; } }
}

#define MFMA16(a, b, c) __builtin_amdgcn_mfma_f32_16x16x32_bf16((a), (b), (c), 0, 0, 0)
__device__ __forceinline__ bf16x8 frag_row(LAS unsigned char* base, int row0, int stride, int k0, int lane) {
    return *(const LAS bf16x8*)(base + (row0 + (lane & 15)) * stride + (k0 + 8 * (lane >> 4)) * 2); }
#define LDS_FENCE() asm volatile("s_waitcnt lgkmcnt(0)" ::: "memory")

#define DPP_F(v, ctrl) __builtin_bit_cast(float, __builtin_amdgcn_update_dpp(0, __builtin_bit_cast(int, (v)), (ctrl), 0xF, 0xF, true))
__device__ __forceinline__ float row16_max(float v) { v = fmaxf(v, DPP_F(v, 0xB1)); v = fmaxf(v, DPP_F(v, 0x4E)); v = fmaxf(v, DPP_F(v, 0x141)); v = fmaxf(v, DPP_F(v, 0x140)); return v; }
__device__ __forceinline__ float row16_sum(float v) { v += DPP_F(v, 0xB1); v += DPP_F(v, 0x4E); v += DPP_F(v, 0x141); v += DPP_F(v, 0x140); return v; }
__device__ __forceinline__ float swap16_add(float a, float b) { const auto r = __builtin_amdgcn_permlane16_swap(__float_as_uint(a), __float_as_uint(b), false, false); return __uint_as_float(r[0]) + __uint_as_float(r[1]); }
__device__ __forceinline__ float swap32_add(float a, float b) { const auto r = __builtin_amdgcn_permlane32_swap(__float_as_uint(a), __float_as_uint(b), false, false); return __uint_as_float(r[0]) + __uint_as_float(r[1]); }
__device__ __forceinline__ float rows4_total(float a, float b, float c, float d) { return swap32_add(swap16_add(a, b), swap16_add(c, d)); }
__device__ __forceinline__ bf16x8 tr_pack(u32x2 lo, u32x2 hi) { u32x4 w; w.x = lo.x; w.y = lo.y; w.z = hi.x; w.w = hi.y; return __builtin_bit_cast(bf16x8, w); }
__device__ __forceinline__ void tr_batch_pv(bf16x8 (&f)[8], unsigned b0) {
    u32x2 r[16];
    asm volatile("ds_read_b64_tr_b16 %0, %16 offset:0\n\t"
        "ds_read_b64_tr_b16 %1, %16 offset:1088\n\t"
        "ds_read_b64_tr_b16 %2, %16 offset:32\n\t"
        "ds_read_b64_tr_b16 %3, %16 offset:1120\n\t"
        "ds_read_b64_tr_b16 %4, %16 offset:64\n\t"
        "ds_read_b64_tr_b16 %5, %16 offset:1152\n\t"
        "ds_read_b64_tr_b16 %6, %16 offset:96\n\t"
        "ds_read_b64_tr_b16 %7, %16 offset:1184\n\t"
        "ds_read_b64_tr_b16 %8, %16 offset:128\n\t"
        "ds_read_b64_tr_b16 %9, %16 offset:1216\n\t"
        "ds_read_b64_tr_b16 %10, %16 offset:160\n\t"
        "ds_read_b64_tr_b16 %11, %16 offset:1248\n\t"
        "ds_read_b64_tr_b16 %12, %16 offset:192\n\t"
        "ds_read_b64_tr_b16 %13, %16 offset:1280\n\t"
        "ds_read_b64_tr_b16 %14, %16 offset:224\n\t"
        "ds_read_b64_tr_b16 %15, %16 offset:1312\n\t"
        "s_waitcnt lgkmcnt(0)"
        : "=&v"(r[0]), "=&v"(r[1]), "=&v"(r[2]), "=&v"(r[3]), "=&v"(r[4]), "=&v"(r[5]), "=&v"(r[6]), "=&v"(r[7]), "=&v"(r[8]), "=&v"(r[9]), "=&v"(r[10]), "=&v"(r[11]), "=&v"(r[12]), "=&v"(r[13]), "=&v"(r[14]), "=&v"(r[15]) : "v"(b0) : "memory");
#pragma unroll
    for (int i = 0; i < 8; ++i) f[i] = tr_pack(r[2 * i], r[2 * i + 1]);
}
__device__ __forceinline__ void tr_batch_s2(bf16x8 (&f)[6], unsigned b0, unsigned b1) {
    u32x2 r[12];
    asm volatile("ds_read_b64_tr_b16 %0, %12 offset:0\n\t"
        "ds_read_b64_tr_b16 %1, %12 offset:576\n\t"
        "ds_read_b64_tr_b16 %2, %12 offset:4608\n\t"
        "ds_read_b64_tr_b16 %3, %12 offset:5184\n\t"
        "ds_read_b64_tr_b16 %4, %13 offset:0\n\t"
        "ds_read_b64_tr_b16 %5, %13 offset:576\n\t"
        "ds_read_b64_tr_b16 %6, %13 offset:4608\n\t"
        "ds_read_b64_tr_b16 %7, %13 offset:5184\n\t"
        "ds_read_b64_tr_b16 %8, %13 offset:9216\n\t"
        "ds_read_b64_tr_b16 %9, %13 offset:9792\n\t"
        "ds_read_b64_tr_b16 %10, %13 offset:13824\n\t"
        "ds_read_b64_tr_b16 %11, %13 offset:14400\n\t"
        "s_waitcnt lgkmcnt(0)"
        : "=&v"(r[0]), "=&v"(r[1]), "=&v"(r[2]), "=&v"(r[3]), "=&v"(r[4]), "=&v"(r[5]), "=&v"(r[6]), "=&v"(r[7]), "=&v"(r[8]), "=&v"(r[9]), "=&v"(r[10]), "=&v"(r[11]) : "v"(b0), "v"(b1) : "memory");
#pragma unroll
    for (int i = 0; i < 6; ++i) f[i] = tr_pack(r[2 * i], r[2 * i + 1]);
}
__device__ __forceinline__ void tr_batch_s3(bf16x8 (&f)[10], unsigned b0, unsigned b1) {
    u32x2 r[20];
    asm volatile("ds_read_b64_tr_b16 %0, %20 offset:0\n\t"
        "ds_read_b64_tr_b16 %1, %20 offset:1088\n\t"
        "ds_read_b64_tr_b16 %2, %20 offset:8704\n\t"
        "ds_read_b64_tr_b16 %3, %20 offset:9792\n\t"
        "ds_read_b64_tr_b16 %4, %21 offset:0\n\t"
        "ds_read_b64_tr_b16 %5, %21 offset:576\n\t"
        "ds_read_b64_tr_b16 %6, %21 offset:4608\n\t"
        "ds_read_b64_tr_b16 %7, %21 offset:5184\n\t"
        "ds_read_b64_tr_b16 %8, %21 offset:32\n\t"
        "ds_read_b64_tr_b16 %9, %21 offset:608\n\t"
        "ds_read_b64_tr_b16 %10, %21 offset:4640\n\t"
        "ds_read_b64_tr_b16 %11, %21 offset:5216\n\t"
        "ds_read_b64_tr_b16 %12, %21 offset:64\n\t"
        "ds_read_b64_tr_b16 %13, %21 offset:640\n\t"
        "ds_read_b64_tr_b16 %14, %21 offset:4672\n\t"
        "ds_read_b64_tr_b16 %15, %21 offset:5248\n\t"
        "ds_read_b64_tr_b16 %16, %21 offset:96\n\t"
        "ds_read_b64_tr_b16 %17, %21 offset:672\n\t"
        "ds_read_b64_tr_b16 %18, %21 offset:4704\n\t"
        "ds_read_b64_tr_b16 %19, %21 offset:5280\n\t"
        "s_waitcnt lgkmcnt(0)"
        : "=&v"(r[0]), "=&v"(r[1]), "=&v"(r[2]), "=&v"(r[3]), "=&v"(r[4]), "=&v"(r[5]), "=&v"(r[6]), "=&v"(r[7]), "=&v"(r[8]), "=&v"(r[9]), "=&v"(r[10]), "=&v"(r[11]), "=&v"(r[12]), "=&v"(r[13]), "=&v"(r[14]), "=&v"(r[15]), "=&v"(r[16]), "=&v"(r[17]), "=&v"(r[18]), "=&v"(r[19]) : "v"(b0), "v"(b1) : "memory");
#pragma unroll
    for (int i = 0; i < 10; ++i) f[i] = tr_pack(r[2 * i], r[2 * i + 1]);
}
constexpr int RS128 = 272, RS64 = 144;
__device__ __forceinline__ void prep_gla_unit(int g, LAS unsigned char* lds) {
    const int tid = threadIdx.x; bf16_t* IN = (bf16_t*)(PWS + WS_IN); const float* SM = (const float*)(PWS + WS_SMALL);
    bf16_t* KDB = (bf16_t*)POUT; float* DECB = (float*)((unsigned char*)POUT + 32 * MiB);
    LAS float* glr = (LAS float*)lds; LAS float* segs = glr + 1024;
    const int b = g >> 8, c = (g >> 2) & 63, h = g & 3, t0 = b * SEQ + c * 64, k = tid & 127, seg = tid >> 7;
    float w2[16]; const float* w2p = PIN(7);
#pragma unroll
    for (int r = 0; r < 16; ++r) w2[r] = w2p[r * 512 + h * 128 + k];
    const float bk = PIN(8)[h * 128 + k];
    unsigned qk[16];
#pragma unroll
    for (int jj = 0; jj < 16; ++jj) { const size_t o = (size_t)(t0 + seg * 16 + jj) * IN_LD; qk[jj] = (unsigned)IN[o + C_Q + h * 128 + k] | ((unsigned)IN[o + C_K + h * 128 + k] << 16); }
    if (tid < 256) *(LAS u32x4*)(glr + (tid >> 2) * 16 + (tid & 3) * 4) = *(const u32x4*)(SM + (size_t)(t0 + (tid >> 2)) * 32 + (tid & 3) * 4);
    __syncthreads();
    float cs[16]; float run = 0.f;
#pragma unroll
    for (int jj = 0; jj < 16; ++jj) { const LAS f32x4* gp = (const LAS f32x4*)(glr + (seg * 16 + jj) * 16); float x = bk;
#pragma unroll
        for (int q4 = 0; q4 < 4; ++q4) { const f32x4 gv = gp[q4]; x += gv[0] * w2[q4 * 4 + 0] + gv[1] * w2[q4 * 4 + 1] + gv[2] * w2[q4 * 4 + 2] + gv[3] * w2[q4 * 4 + 3]; }
        const float lg = (fminf(x, 0.f) - __logf(1.0f + __expf(-fabsf(x)))) * 0.0625f; run += lg; cs[jj] = run; }
    segs[seg * 128 + k] = run;
    __syncthreads();
    float off = 0.f, tot = 0.f;
#pragma unroll
    for (int s = 0; s < 4; ++s) { const float v = segs[s * 128 + k]; tot += v; if (s < seg) off += v; }
    const float etot = __expf(tot);
#pragma unroll
    for (int jj = 0; jj < 16; ++jj) { const float bc = off + cs[jj], qv = __uint_as_float(qk[jj] << 16), kv = __uint_as_float(qk[jj] & 0xffff0000u); const size_t o = (size_t)(t0 + seg * 16 + jj) * IN_LD;
        const float e1 = __expf(bc), e2 = __builtin_amdgcn_rcpf(e1);
        IN[o + C_Q + h * 128 + k] = f2bf(qv * e1); IN[o + C_K + h * 128 + k] = f2bf(kv * e2);
        KDB[(size_t)(t0 + seg * 16 + jj) * 512 + h * 128 + k] = f2bf(kv * (etot * e2)); }
    if (seg == 0) DECB[(size_t)(b * 64 + c) * 512 + h * 128 + k] = etot;
    __syncthreads();
}
__device__ __forceinline__ void prep_conv_unit(int u, LAS unsigned char* lds) {
    const int tid = threadIdx.x; bf16_t* IN = (bf16_t*)(PWS + WS_IN);
    const int b = u / 24, strip = u % 24, r = tid >> 3, c8 = (tid & 7) * 8, col = C_X + strip * 64 + c8, ch = strip * 64 + c8;
    LAS unsigned char* rawt = lds + 16384;
    float wk[4][8], bb[8];
    { const float* cwp = PIN(10); const float* cbp = PIN(11);
#pragma unroll
      for (int kk = 0; kk < 4; ++kk)
#pragma unroll
          for (int e = 0; e < 8; ++e) wk[kk][e] = cwp[kk * 1536 + ch + e];
#pragma unroll
      for (int e = 0; e < 8; ++e) bb[e] = cbp[ch + e]; }
    if (tid < 24) *(LAS u32x4*)(rawt + (189 + (tid >> 3)) * RS64 + (tid & 7) * 16) = (u32x4){0u, 0u, 0u, 0u};
    u32x4 nxt = *(const u32x4*)(IN + (size_t)(b * SEQ + r) * IN_LD + col);
    int slot = 0;
    for (int c = 0; c < 64; ++c) {
        int t0 = b * SEQ + c * 64; asm volatile("" : "+s"(t0));
        *(LAS u32x4*)(rawt + (slot * 64 + r) * RS64 + c8 * 2) = nxt;
        if (c + 1 < 64) nxt = *(const u32x4*)(IN + (size_t)(t0 + 64 + r) * IN_LD + col);
        __syncthreads();
        float a8[8];
#pragma unroll
        for (int e = 0; e < 8; ++e) a8[e] = bb[e];
#pragma unroll
        for (int kk = 0; kk < 4; ++kk) { int row = slot * 64 + r - 3 + kk; row = row < 0 ? row + 192 : row; const u32x4 rv = *(const LAS u32x4*)(rawt + row * RS64 + c8 * 2);
#pragma unroll
            for (int e = 0; e < 4; ++e) { a8[2 * e] += wk[kk][2 * e] * __uint_as_float(rv[e] << 16); a8[2 * e + 1] += wk[kk][2 * e + 1] * __uint_as_float(rv[e] & 0xffff0000u); } }
#pragma unroll
        for (int e = 0; e < 8; ++e) a8[e] = silu_f(a8[e]);
        u32x4 o; o.x = cvt_pk_bf16(a8[0], a8[1]); o.y = cvt_pk_bf16(a8[2], a8[3]); o.z = cvt_pk_bf16(a8[4], a8[5]); o.w = cvt_pk_bf16(a8[6], a8[7]);
        *(u32x4*)(IN + (size_t)(t0 + r) * IN_LD + col) = o;
        slot = slot == 2 ? 0 : slot + 1;
    }
    __syncthreads();
}
__device__ __forceinline__ void phase_prep(LAS unsigned char* lds) {
    const int blk = blockIdx.x;
    if (gridDim.x == 256) {
        if (blk < 192) { prep_conv_unit(blk, lds); for (int i = 0; i < 5; ++i) prep_gla_unit(1088 + blk * 5 + i, lds); }
        else { for (int i = 0; i < 17; ++i) prep_gla_unit((blk - 192) * 17 + i, lds); }
    } else {
        for (int u = blk; u < 192; u += gridDim.x) prep_conv_unit(u, lds);
        for (int g = blk; g < 2048; g += gridDim.x) prep_gla_unit(g, lds);
    }
}

constexpr int SC_QT = 0, SC_KT = 17408, SC_KD = 34816, SC_VV = 52224, SC_AT = 61440, SC_SB = 70656, SC_XS = 89088, SC_MISC = 98304, SC_ZS = 114688;
__device__ __forceinline__ void scan_item(int item, LAS unsigned char* lds, const bool dry, const bool flags8) {
    const int tid0 = threadIdx.x, wid = __builtin_amdgcn_readfirstlane(tid0 >> 6);
    int tid = tid0, lane = tid0 & 63;
    bf16_t* IN = (bf16_t*)(PWS + WS_IN); const float* SM = (const float*)(PWS + WS_SMALL);
    const bool ssd = item >= 128;
    LAS float* misc = (LAS float*)(lds + SC_MISC);
    LAS float* dec = misc + 1536;
    LAS float* dtv = misc + 1792 + wid * 128;
    LAS float* acum = dtv + 64;
    int b, h = 0, vq = 0, hd = 0, grp = 0;
    if (!ssd) { b = item >> 4; h = (item >> 2) & 3; vq = item & 3; } else { const int id = item - 128; b = id >> 4; hd = id & 15; grp = hd >> 3; }
    const int colV = C_V + h * 256 + vq * 64, colZ = C_Z + hd * 64;
    float a_neg = 0.f, dtb = 0.f, Dh = 0.f;
    if (ssd) { a_neg = -__expf(PIN(13)[hd]); dtb = PIN(12)[hd]; Dh = PIN(14)[hd]; }
    const bf16_t* KDB = (const bf16_t*)POUT; const float* DECB = (const float*)((const unsigned char*)POUT + 32 * MiB);
    f32x4 Sacc[4];
#pragma unroll
    for (int i = 0; i < 4; ++i) Sacc[i] = (f32x4){0.f, 0.f, 0.f, 0.f};
    for (int i = tid; i < 128 * RS64 / 4; i += 512) ((LAS unsigned*)(lds + SC_SB))[i] = 0u;
    u32x4 pf[6]; u32x4 vv = {0u, 0u, 0u, 0u}; f32x4 dpf = {0.f, 0.f, 0.f, 0.f};
#pragma unroll
    for (int i = 0; i < 6; ++i) pf[i] = (u32x4){0u, 0u, 0u, 0u};
#define SCAN_PREFETCH(cc) do { int t0p = b * SEQ + (cc) * 64; asm volatile("" : "+s"(t0p)); \
        if (!ssd) { \
            _Pragma("unroll") for (int i = 0; i < 2; ++i) { const int pc = tid + 512 * i, row = pc >> 4, c16 = pc & 15; const size_t o = (size_t)(t0p + row) * IN_LD + h * 128 + c16 * 8; \
                pf[i] = *(const u32x4*)(IN + o + C_Q); pf[2 + i] = *(const u32x4*)(IN + o + C_K); pf[4 + i] = *(const u32x4*)(KDB + (size_t)(t0p + row) * 512 + h * 128 + c16 * 8); } \
            vv = *(const u32x4*)(IN + (size_t)(t0p + (tid >> 3)) * IN_LD + colV + (tid & 7) * 8); \
            if (tid < 32) dpf = *(const f32x4*)(DECB + (size_t)(b * 64 + (cc)) * 512 + h * 128 + tid * 4); \
        } else { \
            pf[0] = *(const u32x4*)(IN + (size_t)(t0p + (tid >> 3)) * IN_LD + C_X + hd * 64 + (tid & 7) * 8); \
            _Pragma("unroll") for (int i = 0; i < 2; ++i) { const int pc = tid + 512 * i, row = pc >> 4, c16 = pc & 15; const size_t o = (size_t)(t0p + row) * IN_LD + grp * 128 + c16 * 8; \
                pf[1 + i] = *(const u32x4*)(IN + o + C_B); pf[3 + i] = *(const u32x4*)(IN + o + C_C); } \
            dpf[0] = SM[(size_t)(t0p + lane) * 32 + 16 + hd]; \
            vv = *(const u32x4*)(IN + (size_t)(t0p + (tid >> 3)) * IN_LD + colZ + (tid & 7) * 8); \
        } } while (0)
    SCAN_PREFETCH(0);
    __syncthreads();

    for (int c = 0; c < 64; ++c) {
        int t0 = b * SEQ + c * 64; asm volatile("" : "+s"(t0));
        tid = tid0; asm volatile("" : "+v"(tid)); lane = tid & 63; const int r16 = lane & 15, g4 = lane >> 4;
        if (!ssd) {
#pragma unroll
            for (int i = 0; i < 2; ++i) { const int pc = tid + 512 * i, row = pc >> 4, c16 = pc & 15;
                *(LAS u32x4*)(lds + SC_QT + row * RS128 + c16 * 16) = pf[i]; *(LAS u32x4*)(lds + SC_KT + row * RS128 + c16 * 16) = pf[2 + i]; *(LAS u32x4*)(lds + SC_KD + row * RS128 + c16 * 16) = pf[4 + i]; }
            *(LAS u32x4*)(lds + SC_VV + (tid >> 3) * RS64 + (tid & 7) * 16) = vv;
            if (tid < 32) *(LAS f32x4*)(dec + tid * 4) = dpf;
        } else {
            float a_last; { const float x = dpf[0] + dtb; const float dt = x > 20.f ? x : __logf(1.0f + __expf(x)); float v = a_neg * dt;
#define SCAN_DPP(x, ctrl, rmask) __builtin_bit_cast(float, __builtin_amdgcn_update_dpp(0, __builtin_bit_cast(int, (x)), (ctrl), (rmask), 0xF, true))
                v += SCAN_DPP(v, 0x111, 0xF); v += SCAN_DPP(v, 0x112, 0xF); v += SCAN_DPP(v, 0x114, 0xF); v += SCAN_DPP(v, 0x118, 0xF);
                v += SCAN_DPP(v, 0x142, 0xA);
                v += SCAN_DPP(v, 0x143, 0xC);
#undef SCAN_DPP
                dtv[lane] = dt; acum[lane] = v; a_last = __builtin_bit_cast(float, __builtin_amdgcn_readlane(__builtin_bit_cast(int, v), 63)); }
            *(LAS u32x4*)(lds + SC_ZS + (tid >> 3) * RS64 + (tid & 7) * 16) = vv;
            *(LAS u32x4*)(lds + SC_XS + (tid >> 3) * RS64 + (tid & 7) * 16) = pf[0];
#pragma unroll
            for (int i = 0; i < 2; ++i) { const int pc = tid + 512 * i, row = pc >> 4, c16 = pc & 15;
                *(LAS u32x4*)(lds + SC_KT + row * RS128 + c16 * 16) = pf[1 + i]; *(LAS u32x4*)(lds + SC_QT + row * RS128 + c16 * 16) = pf[3 + i]; }
            LDS_FENCE();
            { const float d = dtv[tid >> 3]; const u32x4 xv = pf[0]; u32x4 o;
#pragma unroll
              for (int e = 0; e < 4; ++e) o[e] = cvt_pk_bf16(__uint_as_float(xv[e] << 16) * d, __uint_as_float(xv[e] & 0xffff0000u) * d);
              *(LAS u32x4*)(lds + SC_VV + (tid >> 3) * RS64 + (tid & 7) * 16) = o; }
#pragma unroll
            for (int i = 0; i < 2; ++i) { const int pc = tid + 512 * i, row = pc >> 4, c16 = pc & 15; const float d = __expf(a_last - acum[row]); const u32x4 bv = pf[1 + i]; u32x4 o;
#pragma unroll
                for (int e = 0; e < 4; ++e) o[e] = cvt_pk_bf16(__uint_as_float(bv[e] << 16) * d, __uint_as_float(bv[e] & 0xffff0000u) * d);
                *(LAS u32x4*)(lds + SC_KD + row * RS128 + c16 * 16) = o; }
            if (tid >= 384) dec[tid - 384] = __expf(a_last);
        }
        __syncthreads();
        if (flags8) { if (c + 1 < 64) SCAN_PREFETCH(c + 1); __syncthreads(); continue; }
        const int ti = wid >> 1;
        bf16x8 qa[4];
#pragma unroll
        for (int s = 0; s < 4; ++s) qa[s] = frag_row(lds + SC_QT, ti * 16, RS128, 32 * s, lane);
#pragma unroll
        for (int t2 = 0; t2 < 2; ++t2) { const int tj = (wid & 1) * 2 + t2; f32x4 acc = {0.f, 0.f, 0.f, 0.f};
            if (tj <= ti) {
#pragma unroll
                for (int s = 0; s < 4; ++s) acc = MFMA16(qa[s], frag_row(lds + SC_KT, tj * 16, RS128, 32 * s, lane), acc); }
            const int j = tj * 16 + r16; const float aj = ssd ? acum[j] : 0.f;
#pragma unroll
            for (int jj = 0; jj < 4; ++jj) { const int i = ti * 16 + 4 * g4 + jj; float v = (j <= i) ? acc[jj] : 0.f; if (ssd) v *= __expf(fminf(acum[i] - aj, 0.f));
                *(LAS bf16_t*)(lds + SC_AT + i * RS64 + j * 2) = f2bf(v); } }
        {
            float dk[4];
#pragma unroll
            for (int jj = 0; jj < 4; ++jj) dk[jj] = dec[wid * 16 + 4 * g4 + jj];
            bf16x8 f3[10]; { const unsigned lb = (unsigned)(size_t)lds + (unsigned)((lane & 3) * 8), rq = (unsigned)(8 * g4 + (r16 >> 2));
                tr_batch_s3(f3, lb + rq * RS128 + wid * 32 + SC_KD, lb + rq * RS64 + SC_VV); }
#pragma unroll
            for (int tv = 0; tv < 4; ++tv) {
#pragma unroll
                for (int jj = 0; jj < 4; ++jj) Sacc[tv][jj] *= dk[jj];
#pragma unroll
                for (int ks = 0; ks < 2; ++ks) Sacc[tv] = MFMA16(f3[ks], f3[2 + tv * 2 + ks], Sacc[tv]); }
        }
        if (c + 1 < 64) SCAN_PREFETCH(c + 1);
        __syncthreads();
        {
            bf16x8 aa[2];
#pragma unroll
            for (int ks = 0; ks < 2; ++ks) aa[ks] = frag_row(lds + SC_AT, ti * 16, RS64, 32 * ks, lane);
#pragma unroll
            for (int t2 = 0; t2 < 2; ++t2) { const int tv = (wid & 1) * 2 + t2; f32x4 aA = {0.f, 0.f, 0.f, 0.f}, aI = {0.f, 0.f, 0.f, 0.f};
                bf16x8 f2[6]; { const unsigned lb = (unsigned)(size_t)lds + (unsigned)((8 * g4 + (r16 >> 2)) * RS64 + (lane & 3) * 8 + tv * 32); tr_batch_s2(f2, lb + SC_VV, lb + SC_SB); }
#pragma unroll
                for (int ks = 0; ks < 2; ++ks) aA = MFMA16(aa[ks], f2[ks], aA);
#pragma unroll
                for (int ks = 0; ks < 4; ++ks) aI = MFMA16(qa[ks], f2[2 + ks], aI);
                const int v = tv * 16 + r16;
#pragma unroll
                for (int jj = 0; jj < 4; ++jj) { const int i = ti * 16 + 4 * g4 + jj;
                    if (!ssd) { if (!dry) IN[(size_t)(t0 + i) * IN_LD + colV + v] = f2bf(aA[jj] + aI[jj]); }
                    else { const float o = aA[jj] + __expf(acum[i]) * aI[jj]; const float zz = bf2f(*(const LAS bf16_t*)(lds + SC_ZS + i * RS64 + v * 2));
                        const float xs = bf2f(*(const LAS bf16_t*)(lds + SC_XS + i * RS64 + v * 2)); if (!dry) IN[(size_t)(t0 + i) * IN_LD + colZ + v] = f2bf((o + Dh * xs) * silu_f(zz)); } } }
        }
        __syncthreads();
#pragma unroll
        for (int tv = 0; tv < 4; ++tv)
#pragma unroll
            for (int jj = 0; jj < 4; ++jj) *(LAS bf16_t*)(lds + SC_SB + (wid * 16 + 4 * g4 + jj) * RS64 + (tv * 16 + r16) * 2) = f2bf(Sacc[tv][jj]);
    }
    __syncthreads();
#undef SCAN_PREFETCH
}
__device__ __forceinline__ void phase_scan(LAS unsigned char* lds, const bool dry, const bool flags8) { for (int item = blockIdx.x; item < 256; item += gridDim.x) scan_item(item, lds, dry, flags8); }

__device__ __forceinline__ void phase_mixnorm() {
    const int tid = threadIdx.x, wid = tid >> 6, lane = tid & 63; bf16_t* IN = (bf16_t*)(PWS + WS_IN);
    const float* gg = PIN(9); const float* sg = PIN(15);
    for (int row = blockIdx.x * 8 + wid; row < T_TOK; row += gridDim.x * 8) { bf16_t* rp = IN + (size_t)row * IN_LD;
#pragma unroll
        for (int h = 0; h < 4; ++h) { const int j = h * 256 + lane * 4; const u32x2 ov = *(const u32x2*)(rp + C_V + j), rv = *(const u32x2*)(rp + C_R + j);
            float o[4] = {__uint_as_float(ov.x << 16), __uint_as_float(ov.x & 0xffff0000u), __uint_as_float(ov.y << 16), __uint_as_float(ov.y & 0xffff0000u)};
            float rr[4] = {__uint_as_float(rv.x << 16), __uint_as_float(rv.x & 0xffff0000u), __uint_as_float(rv.y << 16), __uint_as_float(rv.y & 0xffff0000u)};
            const float sq = wave_sum((o[0] * o[0] + o[1] * o[1]) + (o[2] * o[2] + o[3] * o[3])); const float rs = rsqrtf(sq * (1.0f / 256.0f) + 1e-6f);
            const f32x4 gv = *(const f32x4*)(gg + j);
            u32x2 w; w.x = cvt_pk_bf16(o[0] * rs * gv[0] * silu_f(rr[0]), o[1] * rs * gv[1] * silu_f(rr[1])); w.y = cvt_pk_bf16(o[2] * rs * gv[2] * silu_f(rr[2]), o[3] * rs * gv[3] * silu_f(rr[3]));
            *(u32x2*)(rp + C_R + j) = w; }
#pragma unroll
        for (int g = 0; g < 2; ++g) { const int j = g * 512 + lane * 8; const u32x4 yv = *(const u32x4*)(rp + C_Z + j); float y[8];
#pragma unroll
            for (int e = 0; e < 4; ++e) { y[2 * e] = __uint_as_float(yv[e] << 16); y[2 * e + 1] = __uint_as_float(yv[e] & 0xffff0000u); }
            float sq = 0.f;
#pragma unroll
            for (int e = 0; e < 8; ++e) sq += y[e] * y[e];
            sq = wave_sum(sq); const float rs = rsqrtf(sq * (1.0f / 512.0f) + 1e-6f);
            const f32x4 g0 = *(const f32x4*)(sg + j), g1 = *(const f32x4*)(sg + j + 4);
            u32x4 w; w.x = cvt_pk_bf16(y[0] * rs * g0[0], y[1] * rs * g0[1]); w.y = cvt_pk_bf16(y[2] * rs * g0[2], y[3] * rs * g0[3]); w.z = cvt_pk_bf16(y[4] * rs * g1[0], y[5] * rs * g1[1]); w.w = cvt_pk_bf16(y[6] * rs * g1[2], y[7] * rs * g1[3]);
            *(u32x4*)(rp + C_Z + j) = w; } }
}

__device__ __forceinline__ void phase_d2() {
    const int tid = threadIdx.x, wid = tid >> 6, lane = tid & 63;
    const float* raw = (const float*)(PWS + WS_RAW1); bf16_t* QL = (bf16_t*)(PWS + WS_QLAT); bf16_t* KV = (bf16_t*)(PWS + WS_KV); bf16_t* KI = (bf16_t*)(PWS + WS_KIDX); float* WI = (float*)(PWS + WS_WIDX);
    const float* qg = PIN(18); const float* kg = PIN(21); const float* lg = PIN(26); const float* lb = PIN(27);
    for (int row = blockIdx.x * 8 + wid; row < T_TOK; row += gridDim.x * 8) { const float* rp = raw + (size_t)row * 512;
        { const f32x4 v = *(const f32x4*)(rp + lane * 4); const float sq = wave_sum((v[0] * v[0] + v[1] * v[1]) + (v[2] * v[2] + v[3] * v[3])); const float rs = rsqrtf(sq * (1.0f / 256.0f) + 1e-6f);
          const f32x4 g = *(const f32x4*)(qg + lane * 4); u32x2 w; w.x = cvt_pk_bf16(v[0] * rs * g[0], v[1] * rs * g[1]); w.y = cvt_pk_bf16(v[2] * rs * g[2], v[3] * rs * g[3]);
          *(u32x2*)(QL + (size_t)row * 256 + lane * 4) = w; }
        { const float a = rp[256 + lane * 2], b = rp[256 + lane * 2 + 1]; const float sq = wave_sum(a * a + b * b); const float rs = rsqrtf(sq * (1.0f / 128.0f) + 1e-6f);
          *(unsigned*)(KV + (size_t)row * 128 + lane * 2) = cvt_pk_bf16(a * rs * kg[lane * 2], b * rs * kg[lane * 2 + 1]); }
        { const float a = rp[384 + lane]; const float mu = wave_sum(a) * (1.0f / 64.0f); const float d = a - mu; const float var = wave_sum(d * d) * (1.0f / 64.0f);
          KI[(size_t)row * 64 + lane] = f2bf(d * rsqrtf(var + 1e-6f) * lg[lane] + lb[lane]); }
        if (lane < 16) WI[(size_t)row * 16 + lane] = rp[448 + lane] * 0.03125f; }
}

constexpr int DS_LIST = 131072, DS_RELB = 139264, DS_BUCK = 141312, DS_QIP = 141824, DS_WIP = 158208;
__device__ __forceinline__ unsigned f2key(float f) { const unsigned u = __float_as_uint(f); return (u & 0x80000000u) ? ~u : (u | 0x80000000u); }
template <int NR> __device__ __forceinline__ unsigned bisect_thr(const unsigned (&r)[NR], int nact, int target) {
    unsigned thr = 0u;
    for (int bit = 31; bit >= 0; --bit) { const unsigned trial = thr | (1u << bit); int cnt = 0; int na = nact; asm volatile("" : "+s"(na));
#pragma unroll
        for (int j4 = 0; j4 < NR / 4; ++j4) { if (j4 * 4 < na) {
#pragma unroll
            for (int e = 0; e < 4; ++e) cnt += __popcll(__ballot(r[j4 * 4 + e] >= trial)); } }
        if (cnt >= target) thr = trial;
        if (cnt == target) break; }
    return thr;
}
template <int NR> __device__ __forceinline__ int count_ge(const unsigned (&r)[NR], int nact, unsigned t) {
    int cnt = 0; int na = nact; asm volatile("" : "+s"(na));
#pragma unroll
    for (int j4 = 0; j4 < NR / 4; ++j4) { if (j4 * 4 < na) {
#pragma unroll
        for (int e = 0; e < 4; ++e) cnt += __popcll(__ballot(r[j4 * 4 + e] >= t)); } }
    return cnt;
}
__device__ __forceinline__ void phase_dsa(LAS unsigned char* lds, const int flags) {
    const int tid = threadIdx.x, wid = __builtin_amdgcn_readfirstlane(tid >> 6), lane = tid & 63, r16 = lane & 15, g4 = lane >> 4;
    const bf16_t* Q = (const bf16_t*)(PWS + WS_Q); bf16_t* OL = (bf16_t*)(PWS + WS_OLAT); const bf16_t* QI = (const bf16_t*)(PWS + WS_QIDX); const bf16_t* KV = (const bf16_t*)(PWS + WS_KV);
    const bf16_t* KI = (const bf16_t*)(PWS + WS_KIDX); const float* WI = (const float*)(PWS + WS_WIDX);
    LAS float* relb = (LAS float*)(lds + DS_RELB); LAS int* buck = (LAS int*)(lds + DS_BUCK);
    relb[tid] = PIN(29)[tid];
    if (tid < 128) { int bk = tid; if (tid >= 16) { const float relf = (float)tid; int lg = 16 + (int)(logf(relf / 16.0f) / 2.0794415416798357f * 16.0f); bk = lg < 31 ? lg : 31; } buck[tid] = bk; }
    __syncthreads();
    LAS unsigned* myslab = (LAS unsigned*)(lds + wid * 16384);
    LAS unsigned* mylist = (LAS unsigned*)(lds + DS_LIST + wid * 1024);
    LAS unsigned char* kvst = lds + wid * 16384;
    LAS unsigned char* pst = lds + wid * 16384 + 8704;
#define DSA_PREFETCH(uu) do { const int ui_ = (uu) >> 8, ub_ = (uu) & 255, b_ = ub_ & 7, xx_ = ub_ >> 3, ti_ = ui_ * 32 + ((ui_ & 1) ? 31 - xx_ : xx_); const int tk_ = b_ * SEQ + ti_ * 8; \
        _Pragma("unroll") for (int i_ = 0; i_ < 2; ++i_) __builtin_amdgcn_global_load_lds((const unsigned*)(QI + (size_t)(tk_ + wid) * 1024 + (i_ * 64 + lane) * 8), (LAS unsigned*)(lds + DS_QIP + wid * 2048 + i_ * 1024), 16, 0, 0); \
        if (wid == 0) __builtin_amdgcn_global_load_lds((const unsigned*)(WI + (size_t)tk_ * 16 + lane * 4), (LAS unsigned*)(lds + DS_WIP), 16, 0, 0); } while (0)
    if ((int)blockIdx.x < 4096) DSA_PREFETCH((int)blockIdx.x);
    asm volatile("s_waitcnt vmcnt(0)" ::: "memory");
    __syncthreads();
    for (int u = blockIdx.x; u < 4096; u += gridDim.x) {
        const int ui = u >> 8, ublk = u & 255, b = ublk & 7, xx = ublk >> 3, ti = ui * 32 + ((ui & 1) ? 31 - xx : xx);
        const int q0 = ti * 8, tok0 = b * SEQ + q0, nkt = (q0 + 8 + 15) >> 4, n16 = nkt * 16;
        {
            bf16x8 qa[8][2]; f32x4 wq[8];
#pragma unroll
            for (int qq = 0; qq < 8; ++qq) { const LAS unsigned char* qp = lds + DS_QIP + qq * 2048 + (r16 * 64 + 8 * g4) * 2;
                qa[qq][0] = *(const LAS bf16x8*)qp; qa[qq][1] = *(const LAS bf16x8*)(qp + 64); wq[qq] = *(const LAS f32x4*)(lds + DS_WIP + qq * 64 + g4 * 16); }
            const int qsel = __ffs((int)rows4_total(1.0f, 2.0f, 4.0f, 8.0f)) - 3;
            const int myq0 = q0 + qsel, myq1 = q0 + 4 + qsel;
            LAS unsigned* slab0 = (LAS unsigned*)(lds + qsel * 16384); LAS unsigned* slab1 = (LAS unsigned*)(lds + (4 + qsel) * 16384);
            const bf16_t* kbase = KI + (size_t)(b * SEQ + r16) * 64 + 8 * g4;
            bf16x8 kc[4][2], kn[4][2];
#pragma unroll
            for (int j = 0; j < 4; ++j) { int kt = wid + 8 * j; kt = kt < nkt ? kt : nkt - 1; const bf16_t* kp = kbase + (size_t)kt * 1024; kn[j][0] = *(const bf16x8*)kp; kn[j][1] = *(const bf16x8*)(kp + 32); }
            for (int kt0 = wid; kt0 < nkt; kt0 += 32) {
#pragma unroll
                for (int j = 0; j < 4; ++j) { kc[j][0] = kn[j][0]; kc[j][1] = kn[j][1]; }
                if (kt0 + 32 < nkt) {
#pragma unroll
                    for (int j = 0; j < 4; ++j) { int kt = kt0 + 32 + 8 * j; kt = kt < nkt ? kt : nkt - 1; const bf16_t* kp = kbase + (size_t)kt * 1024; kn[j][0] = *(const bf16x8*)kp; kn[j][1] = *(const bf16x8*)(kp + 32); } }
#pragma unroll
                for (int j = 0; j < 4; ++j) { const int kt = kt0 + 8 * j;
                    if (kt < nkt) { const int key = kt * 16 + r16;
                        f32x4 acc[8]; float sp[8];
#pragma unroll
                        for (int qq = 0; qq < 8; ++qq) acc[qq] = MFMA16(qa[qq][0], kc[j][0], ((f32x4){0.f, 0.f, 0.f, 0.f}));
#pragma unroll
                        for (int qq = 0; qq < 8; ++qq) acc[qq] = MFMA16(qa[qq][1], kc[j][1], acc[qq]);
#pragma unroll
                        for (int qq = 0; qq < 8; ++qq) {
                            const float r0 = __int_as_float(max(__float_as_int(acc[qq][0]), 0)), r1 = __int_as_float(max(__float_as_int(acc[qq][1]), 0));
                            const float r2 = __int_as_float(max(__float_as_int(acc[qq][2]), 0)), r3 = __int_as_float(max(__float_as_int(acc[qq][3]), 0));
                            sp[qq] = (wq[qq][0] * r0 + wq[qq][1] * r1) + (wq[qq][2] * r2 + wq[qq][3] * r3); }
                        const float t0s = rows4_total(sp[0], sp[1], sp[2], sp[3]) + 0.0f, t1s = rows4_total(sp[4], sp[5], sp[6], sp[7]) + 0.0f;
                        slab0[key] = (key <= myq0) ? f2key(t0s) : 0u; slab1[key] = (key <= myq1) ? f2key(t1s) : 0u; } }
            }
        }
        __syncthreads();
        if (u + (int)gridDim.x < 4096) DSA_PREFETCH(u + (int)gridDim.x);
        if (flags & 2) { asm volatile("s_waitcnt vmcnt(0)" ::: "memory"); __syncthreads(); continue; }
        const int qpos = q0 + wid, n = qpos + 1; int nsel;
        if (n <= 256) { nsel = n; for (int i = lane; i < n; i += 64) mylist[i] = (unsigned)i; }
        else {
            unsigned sv[64]; int nvA = n16; asm volatile("" : "+s"(nvA));
#pragma unroll
            for (int j = 0; j < 64; ++j) { sv[j] = 0u; if (j * 64 < nvA) { const int idx = j * 64 + lane; const unsigned t = myslab[idx]; sv[j] = idx < nvA ? t : 0u; } }
            const int nregs = (n16 + 63) >> 6;
            const unsigned long long lt = (1ull << lane) - 1ull;
            bool done = false;
            if (n16 > 1024) {
                unsigned sub[8];
#pragma unroll
                for (int i = 0; i < 8; ++i) sub[i] = sv[8 * i];
                const unsigned tS = bisect_thr<8>(sub, (nregs + 7) >> 3, 48);
                const int c = count_ge<64>(sv, nregs, tS);
                if (c >= 256 && c <= 1024) {
                    LAS unsigned* candK = myslab; LAS unsigned* candI = myslab + 1024;
                    int npos = 0; int nvC = n16; asm volatile("" : "+s"(nvC));
#pragma unroll
                    for (int jr = 0; jr < 64; ++jr) { if (jr * 64 < nvC) { const unsigned kv = sv[jr]; const bool in = kv >= tS; const unsigned long long m = __ballot(in);
                        const int pos = npos + __popcll(m & lt); if (in) { candK[pos] = kv; candI[pos] = (unsigned)(jr * 64 + lane); } npos += __popcll(m); } }
                    LDS_FENCE();
                    unsigned ck[16]; const int ncr = (c + 63) >> 6;
#pragma unroll
                    for (int jr = 0; jr < 16; ++jr) { ck[jr] = 0u; if (jr < ncr) { const int idx = jr * 64 + lane; const unsigned t = candK[idx]; ck[jr] = idx < c ? t : 0u; } }
                    const unsigned thr = bisect_thr<16>(ck, ncr, 256);
                    int cgt = 0; { int na = ncr; asm volatile("" : "+s"(na));
#pragma unroll
                        for (int jr = 0; jr < 16; ++jr) { if (jr < na) cgt += __popcll(__ballot(ck[jr] > thr)); } }
                    const int need_eq = 256 - cgt; int nout = 0, eq_seen = 0; int nb = ncr; asm volatile("" : "+s"(nb));
#pragma unroll
                    for (int jr = 0; jr < 16; ++jr) { if (jr < nb) { const unsigned kv = ck[jr]; const bool gt = kv > thr, eq = kv == thr && (jr * 64 + lane) < c;
                        const unsigned long long eqm = __ballot(eq);
                        const bool sel = gt || (eq && (eq_seen + __popcll(eqm & lt)) < need_eq);
                        const unsigned long long sm = __ballot(sel); const int pos = nout + __popcll(sm & lt);
                        if (sel && pos < 256) mylist[pos] = candI[jr * 64 + lane];
                        nout += __popcll(sm); eq_seen += __popcll(eqm); } }
                    done = true;
                }
            }
            if (!done) {
                const unsigned thr = bisect_thr<64>(sv, nregs, 256);
                int cgt = 0; int nvB = n16; asm volatile("" : "+s"(nvB));
#pragma unroll
                for (int j4 = 0; j4 < 16; ++j4) { if (j4 * 256 < nvB) {
#pragma unroll
                    for (int e = 0; e < 4; ++e) cgt += __popcll(__ballot(sv[j4 * 4 + e] > thr)); } }
                const int need_eq = 256 - cgt; int nout = 0, eq_seen = 0; int nvC = n16; asm volatile("" : "+s"(nvC));
#pragma unroll
                for (int jr = 0; jr < 64; ++jr) { if (jr * 64 < nvC) { const unsigned kv = sv[jr]; const bool gt = kv > thr, eq = kv == thr;
                    const unsigned long long eqm = __ballot(eq);
                    const bool sel = gt || (eq && (eq_seen + __popcll(eqm & lt)) < need_eq);
                    const unsigned long long sm = __ballot(sel); const int pos = nout + __popcll(sm & lt);
                    if (sel && pos < 256) mylist[pos] = (unsigned)(jr * 64 + lane);
                    nout += __popcll(sm); eq_seen += __popcll(eqm); } }
            }
            nsel = 256;
        }
        LDS_FENCE();
        if (!(flags & 4)) {
            const int tq = tok0 + wid; bf16x8 qf[4];
#pragma unroll
            for (int s = 0; s < 4; ++s) qf[s] = *(const bf16x8*)(Q + (size_t)tq * 2048 + r16 * 128 + 32 * s + 8 * g4);
            f32x4 O[8]; float mrun[4], lrun[4];
#pragma unroll
            for (int i = 0; i < 8; ++i) O[i] = (f32x4){0.f, 0.f, 0.f, 0.f};
#pragma unroll
            for (int i = 0; i < 4; ++i) { mrun[i] = -INFINITY; lrun[i] = 0.f; }
            const int nch = (nsel + 31) >> 5;
            const bf16_t* kvb = KV + (size_t)(b * SEQ) * 128 + (lane & 15) * 8;
            u32x4 g0[8], g1[8];
#pragma unroll
            for (int i = 0; i < 8; ++i) { const int row = (lane >> 4) + 4 * i; const int kidx = row < nsel ? (int)mylist[row] : 0; g0[i] = *(const u32x4*)(kvb + (size_t)kidx * 128); }
#pragma unroll
            for (int i = 0; i < 8; ++i) { const int row = 32 + (lane >> 4) + 4 * i; const int kidx = row < nsel ? (int)mylist[row] : 0; g1[i] = *(const u32x4*)(kvb + (size_t)kidx * 128); }
            for (int ch = 0; ch < nch; ++ch) {
#pragma unroll
                for (int i = 0; i < 8; ++i) { const int row = (lane >> 4) + 4 * i; *(LAS u32x4*)(kvst + row * 272 + (lane & 15) * 16) = g0[i]; g0[i] = g1[i]; }
                if (ch + 2 < nch) {
#pragma unroll
                    for (int i = 0; i < 8; ++i) { const int row = (ch + 2) * 32 + (lane >> 4) + 4 * i; const int kidx = row < nsel ? (int)mylist[row] : 0; g1[i] = *(const u32x4*)(kvb + (size_t)kidx * 128); } }
                LDS_FENCE();
                f32x4 S[2];
#pragma unroll
                for (int t2 = 0; t2 < 2; ++t2) { f32x4 acc = {0.f, 0.f, 0.f, 0.f};
#pragma unroll
                    for (int s = 0; s < 4; ++s) acc = MFMA16(qf[s], frag_row(kvst, t2 * 16, 272, 32 * s, lane), acc);
                    const int kk = ch * 32 + t2 * 16 + r16; const bool valid = kk < nsel; const int skey = valid ? (int)mylist[kk] : 0; const int rel = qpos - skey;
                    const int bk = rel < 128 ? buck[rel < 0 ? 0 : rel] : 31; const f32x4 bias = *(const LAS f32x4*)(relb + bk * 16 + 4 * g4);
#pragma unroll
                    for (int jj = 0; jj < 4; ++jj) S[t2][jj] = valid ? acc[jj] + bias[jj] : -INFINITY; }
                float alpha[4];
#pragma unroll
                for (int jj = 0; jj < 4; ++jj) { const float cm = row16_max(fmaxf(S[0][jj], S[1][jj]));
                    const float mn = fmaxf(mrun[jj], cm); alpha[jj] = __expf(mrun[jj] - mn); mrun[jj] = mn;
                    const float p0 = __expf(S[0][jj] - mn), p1 = __expf(S[1][jj] - mn); lrun[jj] = lrun[jj] * alpha[jj] + p0 + p1;
                    *(LAS bf16_t*)(pst + (4 * g4 + jj) * 80 + r16 * 2) = f2bf(p0); *(LAS bf16_t*)(pst + (4 * g4 + jj) * 80 + (16 + r16) * 2) = f2bf(p1); }
                LDS_FENCE();
                const bf16x8 pa = *(const LAS bf16x8*)(pst + r16 * 80 + g4 * 16);
                bf16x8 vf[8]; tr_batch_pv(vf, (unsigned)(size_t)kvst + (unsigned)((8 * g4 + (r16 >> 2)) * 272 + (lane & 3) * 8));
                if (__ballot(alpha[0] != 1.0f || alpha[1] != 1.0f || alpha[2] != 1.0f || alpha[3] != 1.0f) != 0ull) {
#pragma unroll
                    for (int ct = 0; ct < 8; ++ct)
#pragma unroll
                        for (int jj = 0; jj < 4; ++jj) O[ct][jj] *= alpha[jj]; }
#pragma unroll
                for (int ct = 0; ct < 8; ++ct) O[ct] = MFMA16(pa, vf[ct], O[ct]);
            }
#pragma unroll
            for (int jj = 0; jj < 4; ++jj) { const float inv = 1.0f / row16_sum(lrun[jj]);
#pragma unroll
                for (int ct = 0; ct < 8; ++ct) OL[(size_t)tq * 2048 + (4 * g4 + jj) * 128 + ct * 16 + r16] = f2bf(O[ct][jj] * inv); }
        }
        asm volatile("s_waitcnt vmcnt(0)" ::: "memory");
        __syncthreads();
    }
#undef DSA_PREFETCH
}

__device__ __forceinline__ void phase_final() {
    const float* ss = (const float*)(PWS + WS_SS); const float* g = PIN(30); float* out = POUT; const bf16_t* XB = (const bf16_t*)(PWS + WS_XB);
    for (size_t i = (size_t)blockIdx.x * 512 + threadIdx.x; i < (size_t)T_TOK * 256; i += (size_t)gridDim.x * 512) { const int row = (int)(i >> 8), c = (int)(i & 255) * 4;
        const float rs = row_rstd(ss, row); const u32x2 q = *(const u32x2*)(XB + (size_t)row * DM + c); const f32x4 gv = *(const f32x4*)(g + c);
        f32x4 v; v[0] = __uint_as_float(q.x << 16); v[1] = __uint_as_float(q.x & 0xffff0000u); v[2] = __uint_as_float(q.y << 16); v[3] = __uint_as_float(q.y & 0xffff0000u);
        *(f32x4*)(out + (size_t)row * DM + c) = v * rs * gv; }
}

#define XB_TMO      128
#define XB_XCNT(j)  (256  + 64 * (j))
#define XB_XSUB(j)  (1280 + 64 * (j))
#define XB_XGEN(j)  (2304 + 64 * (j))
#define XB_TOP      3328
#define XB_TOPGEN   3392
#define XCD_BAR_WORDS 3456
#define XB_SPIN_CAP (1u << 18)

__device__ __forceinline__ unsigned xb_ld(unsigned* p)              { return __hip_atomic_load(p, __ATOMIC_RELAXED, __HIP_MEMORY_SCOPE_AGENT); }
__device__ __forceinline__ unsigned xb_add(unsigned* p, unsigned v) { return __hip_atomic_fetch_add(p, v, __ATOMIC_RELAXED, __HIP_MEMORY_SCOPE_AGENT); }
__device__ __forceinline__ unsigned xb_xcc_id() { return (unsigned)__builtin_amdgcn_s_getreg((3 << 11) | 20) & 0xFu; }
#define XB_SPIN(cond, bar) do { unsigned _sp = 0; while (cond) { __builtin_amdgcn_s_sleep(1); \
    if ((++_sp & 255u) == 0u) { if (xb_ld(&(bar)[XB_TMO])) break; if (_sp > XB_SPIN_CAP) { atomicAdd(&(bar)[XB_TMO], 1u); break; } } } } while (0)

struct XcdBarrier {
    unsigned* bar; unsigned x;
    volatile LAS unsigned* st;
};

__device__ __forceinline__ XcdBarrier xcd_barrier_post(unsigned* bar, volatile LAS unsigned* st) {
    XcdBarrier b; b.bar = bar; b.x = xb_xcc_id(); b.st = st;
    if (threadIdx.x == 0) (void)xb_add(&bar[XB_XCNT(b.x)], 1u);
    return b;
}
__device__ __forceinline__ void xcd_barrier_complete(unsigned* bar, unsigned x, unsigned& nloc, unsigned& nx) {
    const unsigned G = gridDim.x * gridDim.y * gridDim.z;
    unsigned sum, cnt, mine, sp = 0u;
    for (;;) {
        sum = 0u; cnt = 0u; mine = 0u;
#pragma unroll
        for (unsigned j = 0; j < 16; ++j) { const unsigned c = xb_ld(&bar[XB_XCNT(j)]); sum += c; cnt += (c > 0u) ? 1u : 0u; mine = (j == x) ? c : mine; }
        if (sum == G) break;
        __builtin_amdgcn_s_sleep(1);
        if ((++sp & 255u) == 0u) { if (xb_ld(&bar[XB_TMO])) break; if (sp > XB_SPIN_CAP) { atomicAdd(&bar[XB_TMO], 1u); break; } }
    }
    nloc = mine > 0u ? mine : 1u; nx = cnt > 0u ? cnt : 1u;
}

__device__ __forceinline__ void xcd_barrier(const XcdBarrier& b) {
    asm volatile("s_waitcnt vmcnt(0)" ::: "memory");
    __syncthreads();
    if (threadIdx.x == 0) {
        unsigned* bar = b.bar;
        __builtin_amdgcn_s_waitcnt(0);
        unsigned nloc = b.st[0], nx = b.st[1];
        if (nloc == 0u) { xcd_barrier_complete(bar, b.x, nloc, nx); b.st[0] = nloc; b.st[1] = nx; }
        const unsigned old = xb_add(&bar[XB_XSUB(b.x)], 1u);
        const unsigned gen = old / nloc;
        if (old + 1u == (gen + 1u) * nloc) {
            __builtin_amdgcn_fence(__ATOMIC_RELEASE, "agent");
            asm volatile("s_waitcnt vmcnt(0)" ::: "memory");
            const unsigned og = xb_add(&bar[XB_TOP], 1u);
            const unsigned tg = og / nx;
            if (og + 1u == (tg + 1u) * nx) xb_add(&bar[XB_TOPGEN], 1u);
            else XB_SPIN(xb_ld(&bar[XB_TOPGEN]) == tg, bar);
            __builtin_amdgcn_fence(__ATOMIC_ACQUIRE, "agent");
            xb_add(&bar[XB_XGEN(b.x)], 1u);
            asm volatile("s_waitcnt vmcnt(0)" ::: "memory");
        } else {
            XB_SPIN(xb_ld(&bar[XB_XGEN(b.x)]) == gen, bar);
            __builtin_amdgcn_fence(__ATOMIC_ACQUIRE, "agent");
            asm volatile("s_waitcnt vmcnt(0)" ::: "memory");
        }
    }
    __syncthreads();
}


constexpr int N_PHASES = 20;
__global__ void __launch_bounds__(512, 2) fwd_mega(Params p) {
    extern __shared__ __attribute__((aligned(16))) unsigned char shm[];
    LAS unsigned char* lds = (LAS unsigned char*)shm;
    cg::grid_group grid = cg::this_grid();
    const int ph_lo = PARG_I(264), ph_hi = PARG_I(268), flags = PARG_I(272);
    volatile LAS unsigned* xst = (volatile LAS unsigned*)(lds + LDS_BYTES - 16);
    if (threadIdx.x == 0) { xst[0] = 0u; xst[1] = 0u; xst[2] = 0u; xst[3] = 0u; }
    __syncthreads();
    const XcdBarrier xbar = xcd_barrier_post((unsigned*)(PWS + WS_BAR), xst);
#define ws PWS
#define gXB ((bf16_t*)(PWS + WS_XB))
#define gSS ((float*)(PWS + WS_SS))
#define gACT ((bf16_t*)(PWS + WS_ACT))
#define gIN ((bf16_t*)(PWS + WS_IN))
#ifndef KEEPMASK
#define KEEPMASK 0xFFFFFFFFu
#endif
#define PHASE(n, ...) if (((KEEPMASK >> (n)) & 1u) && ph_lo <= (n) && (n) < ph_hi) { __VA_ARGS__; if ((n) + 1 < ph_hi) xcd_barrier(xbar); }
#define GU_PHASE(n, lf) PHASE(n, { EpiGU E; E.act = gACT; E.ss = gSS; E.cpm = -1; run_gemm(lds, gXB, 1024, (const bf16_t*)(ws + W_GU + (lf) * W_GU_SZ), T_TOK, 5632, 1024, E, 16); })
#define DN_PHASE(n, lf, RES) PHASE(n, { EpiRes E; E.res32 = (RES); E.XB = gXB; E.ss = gSS; run_gemm(lds, gACT, 2816, (const bf16_t*)(ws + W_D + (lf) * W_D_SZ), T_TOK, 1024, 2816, E); })
    if (ph_lo == 100) { for (int i = 0; i < 20; ++i) grid.sync(); }
    PHASE(0, phase_prologue(lds))
    GU_PHASE(1, 0)
    DN_PHASE(2, 0, PIN(0))
    PHASE(3, { EpiIn E; E.IN = gIN; E.small = (float*)(ws + WS_SMALL); E.ss = gSS; E.cpm = -1; run_gemm(lds, gXB, 1024, (const bf16_t*)(ws + W_IN), T_TOK, 5888, 1024, E, 16); })
    PHASE(4, phase_prep(lds))
    PHASE(5, phase_scan(lds, (flags & 1) != 0, (flags & 8) != 0))
    PHASE(6, phase_mixnorm())
    PHASE(7, { EpiRes E; E.res32 = nullptr; E.XB = gXB; E.ss = gSS; run_gemm(lds, gIN + C_R, IN_LD, (const bf16_t*)(ws + W_OUT), T_TOK, 1024, 2048, E); })
    GU_PHASE(8, 1)
    DN_PHASE(9, 1, (const float*)nullptr)
    GU_PHASE(10, 2)
    DN_PHASE(11, 2, (const float*)nullptr)
    if (gridDim.x == 256) {
        PHASE(12, { EpiD1F E; E.ss = gSS; E.QL = (bf16_t*)(ws + WS_QLAT); E.KV = (bf16_t*)(ws + WS_KV); E.KI = (bf16_t*)(ws + WS_KIDX); E.WI = (float*)(ws + WS_WIDX);
            E.qg = PIN(18); E.kg = PIN(21); E.lg = PIN(26); E.lb = PIN(27); E.cpm = -1; run_gemm(lds, gXB, 1024, (const bf16_t*)(ws + W_D1), T_TOK, 512, 1024, E); })
    } else {
        PHASE(12, { EpiD1 E; E.raw = (float*)(ws + WS_RAW1); E.ss = gSS; E.cpm = -1; run_gemm(lds, gXB, 1024, (const bf16_t*)(ws + W_D1), T_TOK, 512, 1024, E); })
        PHASE(13, phase_d2())
    }
    PHASE(14, { EpiD3 E; E.Q = (bf16_t*)(ws + WS_Q); E.QI = (bf16_t*)(ws + WS_QIDX); run_gemm(lds, (const bf16_t*)(ws + WS_QLAT), 256, (const bf16_t*)(ws + W_D3), T_TOK, 3072, 256, E); })
    PHASE(15, phase_dsa(lds, flags))
    PHASE(16, { EpiRes E; E.res32 = nullptr; E.XB = gXB; E.ss = gSS; run_gemm(lds, (const bf16_t*)(ws + WS_OLAT), 2048, (const bf16_t*)(ws + W_C), T_TOK, 1024, 2048, E); })
    GU_PHASE(17, 3)
    DN_PHASE(18, 3, (const float*)nullptr)
    PHASE(19, phase_final())
#undef ws
}

extern "C" void kernel_launch(void* const* d_in, const int* in_sizes, int n_in, void* d_out, int out_size, void* d_ws, size_t ws_size, hipStream_t stream) {
    static int grid = 0;
    if (grid == 0) {
        int dev = 0, cus = 0, per_cu = 0;
        hipGetDevice(&dev); hipDeviceGetAttribute(&cus, hipDeviceAttributeMultiprocessorCount, dev);
        hipFuncSetAttribute((const void*)fwd_mega, hipFuncAttributeMaxDynamicSharedMemorySize, LDS_BYTES);
        hipOccupancyMaxActiveBlocksPerMultiprocessor(&per_cu, (const void*)fwd_mega, 512, LDS_BYTES);
        (void)hipGetLastError();
        if (per_cu < 1) per_cu = 1;
        grid = cus > 0 ? cus : 256;
        if (n_in != 31 || ws_size < WS_END) fprintf(stderr, "kernel_launch: unexpected n_in %d / ws_size %zu (need %zu)\n", n_in, ws_size, (size_t)WS_END);
    }
#ifndef PROBE_SEQ
#define PROBE_SEQ {0, N_PHASES, 0}
#endif
    static const int seq[][3] = { PROBE_SEQ };
    for (unsigned li = 0; li < sizeof(seq) / sizeof(seq[0]); ++li) {
        Params p{};
        for (int i = 0; i < 31; ++i) p.in[i] = (const float*)d_in[i];
        p.out = (float*)d_out; p.ws = (unsigned char*)d_ws; p.ph_lo = seq[li][0]; p.ph_hi = seq[li][1]; p.flags = seq[li][2];
        (void)hipMemsetAsync((unsigned char*)d_ws + WS_BAR, 0, XCD_BAR_WORDS * sizeof(unsigned), stream);
        void* args[] = {&p};
        hipError_t e = hipLaunchCooperativeKernel((const void*)fwd_mega, dim3(grid), dim3(512), args, LDS_BYTES, stream);
        if (e != hipSuccess) fprintf(stderr, "cooperative launch failed: %s (grid %d)\n", hipGetErrorString(e), grid);
    }
}
```
